# Optimizing an MI355X kernel written in HIP

```python
import jax
import jax.numpy as jnp
from jax import lax
import numpy as np

D_MODEL = 2048
BATCH = 2
SEQ = 8192
DEPTH = 4

CHUNK = 64
Q_BLOCK = 128
MIX_WIDTH = D_MODEL
HG_WIDTH = MIX_WIDTH // 2
SB_WIDTH = MIX_WIDTH - HG_WIDTH
HG_HEAD_DIM = 128
HG_HEADS = HG_WIDTH // HG_HEAD_DIM
SB_HEAD_DIM = 128
SB_HEADS = SB_WIDTH // SB_HEAD_DIM
D_FF = -(-(8 * D_MODEL) // (3 * 256)) * 256
IN_COLS = 4 * HG_WIDTH + 3 * SB_WIDTH
IN_SPLITS = (HG_WIDTH, 2 * HG_WIDTH, 3 * HG_WIDTH, 4 * HG_WIDTH,
             4 * HG_WIDTH + SB_WIDTH, 4 * HG_WIDTH + 2 * SB_WIDTH)
N_MOD = 6
EPS = 1e-6
TINY = 1e-30

kernel_name = "hymba_hgrn2_stickbreaking_adaln_trunk"


def rms_norm(x, g):
    xf = x.astype(jnp.float32)
    y = xf * lax.rsqrt(jnp.mean(xf * xf, axis=-1, keepdims=True) + EPS)
    return (y * g.astype(jnp.float32)).astype(x.dtype)


def hgrn2_mixer(q, f_logit, v, g, lb, out_g):
    bsz, seq, _ = q.shape
    n_chunks = seq // CHUNK
    f32 = jnp.float32
    lb = lb.astype(f32)
    fl = f_logit.astype(f32)
    q_act = jax.nn.silu(q.astype(f32))
    forget = lb + (1.0 - lb) * jax.nn.sigmoid(fl)
    log_f = jnp.log(jnp.maximum(forget, TINY))
    key = (1.0 - lb) * jax.nn.sigmoid(-fl)

    def to_chunks(t):
        return t.reshape(bsz, n_chunks, CHUNK, HG_HEADS, HG_HEAD_DIM).transpose(1, 0, 3, 2, 4)

    causal = jnp.tril(jnp.ones((CHUNK, CHUNK), dtype=bool))[:, :, None]

    def chunk_step(state, inp):
        q_c, k_c, v_c, lf_c = inp
        b = jnp.cumsum(lf_c, axis=2)
        diff = b[:, :, :, None, :] - b[:, :, None, :, :]
        decay = jnp.where(causal, jnp.exp(jnp.where(causal, diff, 0.0)), 0.0)
        scores = jnp.einsum('bhtd,bhsd,bhtsd->bhts', q_c, k_c, decay)
        o_intra = jnp.einsum('bhts,bhsv->bhtv', scores, v_c)
        o_inter = jnp.einsum('bhtd,bhdv->bhtv', q_c * jnp.exp(b), state)
        b_last = b[:, :, -1, :]
        k_to_end = k_c * jnp.exp(b_last[:, :, None, :] - b)
        state = jnp.exp(b_last)[..., None] * state + jnp.einsum('bhsd,bhsv->bhdv', k_to_end, v_c)
        return state, o_intra + o_inter

    state0 = jnp.zeros((bsz, HG_HEADS, HG_HEAD_DIM, HG_HEAD_DIM), f32)
    _, o = lax.scan(chunk_step, state0,
                    (to_chunks(q_act), to_chunks(key), to_chunks(v.astype(f32)), to_chunks(log_f)))
    o = o.transpose(1, 0, 3, 2, 4).reshape(bsz, seq, HG_HEADS, HG_HEAD_DIM)
    o = rms_norm(o, out_g.reshape(HG_HEADS, HG_HEAD_DIM))
    return o.reshape(bsz, seq, HG_WIDTH) * jax.nn.silu(g.astype(f32))


def stick_breaking_mixer(q, k, v, q_g, k_g, out_g):
    bsz, seq, _ = q.shape
    f32 = jnp.float32

    def heads(t):
        return t.astype(f32).reshape(bsz, seq, SB_HEADS, SB_HEAD_DIM).transpose(0, 2, 1, 3)

    qh = rms_norm(heads(q), q_g)
    kh = rms_norm(heads(k), k_g)
    vh = heads(v)
    key_pos = jnp.arange(seq)
    scale = SB_HEAD_DIM ** -0.5

    def query_block(blk):
        q0 = blk * Q_BLOCK
        qb = lax.dynamic_slice_in_dim(qh, q0, Q_BLOCK, axis=2)
        z = jnp.einsum('bhqd,bhkd->bhqk', qb, kh) * scale
        q_pos = q0 + jnp.arange(Q_BLOCK)
        earlier = key_pos[None, :] < q_pos[:, None]
        log_keep = jnp.where(earlier, jax.nn.log_sigmoid(-z), 0.0)
        log_keep_between = lax.cumsum(log_keep, axis=3, reverse=True) - log_keep
        a = jnp.where(earlier, jnp.exp(jax.nn.log_sigmoid(z) + log_keep_between), 0.0)
        return jnp.einsum('bhqk,bhkv->bhqv', a, vh)

    o = lax.map(query_block, jnp.arange(seq // Q_BLOCK))
    o = o.transpose(1, 0, 3, 2, 4).reshape(bsz, seq, SB_HEADS, SB_HEAD_DIM)
    o = rms_norm(o, out_g.reshape(SB_HEADS, SB_HEAD_DIM))
    return o.reshape(bsz, seq, SB_WIDTH)


def setup_inputs(seed: int = 0) -> dict:
    key = jax.random.key(seed)
    ks = jax.random.split(key, 16)
    f32 = jnp.float32

    def normal(k, shape, scale):
        return jax.random.normal(k, shape, f32) * scale

    def gain(k, shape):
        return 1.0 + 0.02 * jax.random.normal(k, shape, f32)

    return {
        'x': normal(ks[0], (BATCH, SEQ, D_MODEL), 1.0),
        'c': normal(ks[1], (BATCH, D_MODEL), 1.0),
        'norm1_g': gain(ks[2], (DEPTH, D_MODEL)),
        'w_in': normal(ks[3], (DEPTH, D_MODEL, IN_COLS), D_MODEL ** -0.5),
        'hg_lb_logits': normal(ks[4], (DEPTH, HG_WIDTH), 0.5),
        'hg_out_g': gain(ks[5], (DEPTH, HG_WIDTH)),
        'sb_q_g': gain(ks[6], (DEPTH, SB_HEAD_DIM)),
        'sb_k_g': gain(ks[7], (DEPTH, SB_HEAD_DIM)),
        'sb_out_g': gain(ks[8], (DEPTH, SB_WIDTH)),
        'w_out': normal(ks[9], (DEPTH, MIX_WIDTH, D_MODEL), MIX_WIDTH ** -0.5),
        'norm2_g': gain(ks[10], (DEPTH, D_MODEL)),
        'w_ffn_in': normal(ks[11], (DEPTH, D_MODEL, 2 * D_FF), D_MODEL ** -0.5),
        'w_ffn_out': normal(ks[12], (DEPTH, D_FF, D_MODEL), D_FF ** -0.5),
        'w_ada': normal(ks[13], (DEPTH, D_MODEL, N_MOD * D_MODEL), 0.5 * D_MODEL ** -0.5),
        'b_ada': normal(ks[14], (DEPTH, N_MOD * D_MODEL), 0.01),
    }


def reference(x, c, norm1_g, w_in, hg_lb_logits, hg_out_g, sb_q_g, sb_k_g, sb_out_g,
              w_out, norm2_g, w_ffn_in, w_ffn_out, w_ada, b_ada):
    lb_soft = jax.nn.softmax(hg_lb_logits.astype(jnp.float32), axis=0)
    lower_bounds = jnp.cumsum(lb_soft, axis=0) - lb_soft[0]
    cond = jax.nn.silu(c)
    for layer in range(DEPTH):
        mod = cond @ w_ada[layer] + b_ada[layer]
        sh1, sc1, g1, sh2, sc2, g2 = [m[:, None, :] for m in jnp.split(mod, N_MOD, axis=-1)]

        h = rms_norm(x, norm1_g[layer]) * (1.0 + sc1) + sh1
        proj = h @ w_in[layer]
        hg_q, hg_f, hg_i, hg_g, sb_q, sb_k, sb_v = jnp.split(proj, IN_SPLITS, axis=-1)
        o_hg = hgrn2_mixer(hg_q, hg_f, hg_i, hg_g, lower_bounds[layer], hg_out_g[layer])
        o_sb = stick_breaking_mixer(sb_q, sb_k, sb_v, sb_q_g[layer], sb_k_g[layer], sb_out_g[layer])
        mixed = jnp.concatenate([o_hg, o_sb], axis=-1).astype(x.dtype) @ w_out[layer]
        x = x + g1 * mixed

        h = rms_norm(x, norm2_g[layer]) * (1.0 + sc2) + sh2
        gate, up = jnp.split(h @ w_ffn_in[layer], 2, axis=-1)
        x = x + g2 * ((jax.nn.silu(gate) * up) @ w_ffn_out[layer])
    return x
```

```cpp
#include <hip/hip_runtime.h>
#include <cstdio>
#include <cstdint>
namespace pg8 {
#define PG8_LAS __attribute__((address_space(3)))
typedef unsigned short bf16_t;
typedef short bf16x8 __attribute__((ext_vector_type(8)));
typedef float f32x4 __attribute__((ext_vector_type(4)));
typedef unsigned u32x4 __attribute__((ext_vector_type(4)));
constexpr int BM = 256, BK = 64, HALF = 128, HTB = HALF * BK * 2  , STAGE_BYTES = 8 * HTB, NXCD = 8, WGM = 8;

__host__ __device__ __forceinline__ int lds_byte(int r, int c) { const int st = (r >> 4) * 2 + (c >> 5), rr = r & 15, cc = c & 31, ob = rr * 64 + cc * 2; return st * 1024 + (ob ^ (((ob >> 9) & 1) << 5)); }
__host__ __device__ __forceinline__ void stage_rc(int b, int& R, int& C) { const int st = b / 1024, sb = b % 1024, swz = sb ^ (((sb >> 9) & 1) << 5); R = (st >> 1) * 16 + swz / 64; C = (st & 1) * 32 + (swz % 64) / 2; }
__host__ __device__ __forceinline__ int perm32(int rho) { const int n = rho >> 4, i = rho & 15; return 8 * (i >> 2) + 4 * n + (i & 3); }

struct Unit { int pm, pn; };
struct Gemm { const bf16_t* A; const bf16_t* Bt; int M, N, K; };

struct StaticOrder {
    int nM, nN, nwg, G, c;
    __host__ __device__ void init(int M, int N, int G_, int c_) { nM = M / BM; nN = N / BM; nwg = nM * nN; G = G_; c = c_; }
    __host__ __device__ bool next(int i, Unit& u) const {
        const long L = (long)i * G + c; if (L >= nwg) return false;
        int wgid = (int)L; { const int q = nwg / NXCD, r = nwg % NXCD, xcd = wgid % NXCD, off = wgid / NXCD; wgid = (xcd < r ? xcd * (q + 1) : r * (q + 1) + (xcd - r) * q) + off; }
        const int nig = WGM * nN, gid = wgid / nig, fm = gid * WGM, gsz = (nM - fm) < WGM ? (nM - fm) : WGM;
        u.pm = fm + ((wgid % nig) % gsz); u.pn = (wgid % nig) / gsz; return true;
    }
    __device__ __forceinline__ void a_ready(const Unit&) const {}
    __device__ __forceinline__ void done(const Unit&) const {}
};

__device__ __forceinline__ unsigned cvt_pk_bf16(float lo, float hi) { unsigned r; asm volatile("v_cvt_pk_bf16_f32 %0, %1, %2" : "=v"(r) : "v"(lo), "v"(hi)); return r; }
__device__ __forceinline__ unsigned cvt_pk_f16(float lo, float hi) { typedef _Float16 h2 __attribute__((ext_vector_type(2))); h2 v; v.x = (_Float16)lo; v.y = (_Float16)hi; return __builtin_bit_cast(unsigned, v); }
__device__ __forceinline__ float fsilu(float x) { return x * __builtin_amdgcn_rcpf(1.0f + __expf(-x)); }

constexpr int P16_LD = 8192;
constexpr float RMS_EPS = 1e-6f;
__device__ __forceinline__ void fx_add(long long* p, float v, float scale) { atomicAdd((unsigned long long*)p, (unsigned long long)__float2ll_rn(v * scale)); }
__device__ __forceinline__ float fx_get(const long long* p, float inv_scale) { return (float)(*p) * inv_scale; }
constexpr float SS_SCALE = 65536.0f, SS_INV = 1.0f / 65536.0f, C_SCALE = 4294967296.0f, C_INV = 1.0f / 4294967296.0f;
struct EpiProj {
    static constexpr bool PERM = true, AFTER_DRAIN = false;
    bf16_t* P; const float* lb;
    const long long* ss; const float* cvec; int cstride, rows_per_batch;
    __device__ __forceinline__ void operator()(const f32x4 (&acc)[2][2][4][2], const Unit& u, int wr, int wc, int fr, int fq) const {
        const int sec = u.pn >> 2;
        const int row0 = u.pm * BM + wr * 64 + fr, col0 = u.pn * BM + wc * 32 + 8 * fq;
        const float* cb = cvec + (size_t)((u.pm * BM) / rows_per_batch) * cstride + col0;
        const float* lbp = lb + ((sec == 1) ? (col0 - 1024) : 0);
        long long sv[2][4]; f32x4 cc[2][2], ll[2][2];
#pragma unroll
        for (int ai = 0; ai < 2; ++ai)
#pragma unroll
            for (int m = 0; m < 4; ++m) sv[ai][m] = ss[row0 + ai * HALF + m * 16];
#pragma unroll
        for (int bj = 0; bj < 2; ++bj) { cc[bj][0] = *(const f32x4*)(cb + bj * HALF); cc[bj][1] = *(const f32x4*)(cb + bj * HALF + 4);
            ll[bj][0] = *(const f32x4*)(lbp + bj * HALF); ll[bj][1] = *(const f32x4*)(lbp + bj * HALF + 4); }
        asm volatile("" : "+v"(sv[0][0]), "+v"(sv[0][1]), "+v"(sv[0][2]), "+v"(sv[0][3]), "+v"(sv[1][0]), "+v"(sv[1][1]), "+v"(sv[1][2]), "+v"(sv[1][3]),
                          "+v"(cc[0][0]), "+v"(cc[0][1]), "+v"(cc[1][0]), "+v"(cc[1][1]), "+v"(ll[0][0]), "+v"(ll[0][1]), "+v"(ll[1][0]), "+v"(ll[1][1]));
        float rstd[2][4];
#pragma unroll
        for (int ai = 0; ai < 2; ++ai)
#pragma unroll
            for (int m = 0; m < 4; ++m) rstd[ai][m] = __builtin_amdgcn_rsqf((float)sv[ai][m] * (SS_INV * (1.0f / 2048.0f)) + RMS_EPS);
#pragma unroll
        for (int bj = 0; bj < 2; ++bj) {
            const f32x4 c0 = cc[bj][0], c1 = cc[bj][1];
            if (sec == 1) {
                const f32x4 l0 = ll[bj][0], l1 = ll[bj][1];
#pragma unroll
                for (int ai = 0; ai < 2; ++ai)
#pragma unroll
                    for (int m = 0; m < 4; ++m) { bf16_t* rowp = P + (size_t)(row0 + ai * HALF + m * 16) * P16_LD + col0 + bj * HALF; float lf[8];
#pragma unroll
                        for (int j = 0; j < 4; ++j) { const float fl0 = acc[ai][bj][m][0][j] * rstd[ai][m] + c0[j], fl1 = acc[ai][bj][m][1][j] * rstd[ai][m] + c1[j];
                            const float r0 = __builtin_amdgcn_rcpf(1.0f + __expf(-fl0)), r1 = __builtin_amdgcn_rcpf(1.0f + __expf(-fl1));
                            lf[j] = 0.6931471805599453f * __builtin_amdgcn_logf(fmaxf(l0[j] + (1.0f - l0[j]) * r0, 1e-30f)); lf[4 + j] = 0.6931471805599453f * __builtin_amdgcn_logf(fmaxf(l1[j] + (1.0f - l1[j]) * r1, 1e-30f)); }
                        u32x4 w; w.x = cvt_pk_f16(lf[0], lf[1]); w.y = cvt_pk_f16(lf[2], lf[3]); w.z = cvt_pk_f16(lf[4], lf[5]); w.w = cvt_pk_f16(lf[6], lf[7]);
                        *(u32x4*)(rowp) = w; }
            } else {
                const bool act = (sec == 0) || (sec == 3);
#pragma unroll
                for (int ai = 0; ai < 2; ++ai)
#pragma unroll
                    for (int m = 0; m < 4; ++m) { bf16_t* rowp = P + (size_t)(row0 + ai * HALF + m * 16) * P16_LD + col0 + bj * HALF;
                        f32x4 v0 = acc[ai][bj][m][0] * rstd[ai][m] + c0, v1 = acc[ai][bj][m][1] * rstd[ai][m] + c1;
                        if (act) {
#pragma unroll
                            for (int j = 0; j < 4; ++j) { v0[j] = fsilu(v0[j]); v1[j] = fsilu(v1[j]); } }
                        u32x4 w; w.x = cvt_pk_bf16(v0[0], v0[1]); w.y = cvt_pk_bf16(v0[2], v0[3]); w.z = cvt_pk_bf16(v1[0], v1[1]); w.w = cvt_pk_bf16(v1[2], v1[3]);
                        *(u32x4*)(rowp) = w; }
            }
        }
    }
};
template <bool OUT_DELTA, bool HAS_DIN> struct EpiResid {
    static constexpr bool PERM = true, AFTER_DRAIN = false;
    const float* base; float* out; bf16_t* dbuf; const float* gate; int gate_bstride, rows_per_batch;
    bf16_t* Hn; const float* gnext; const float* scnext; long long* ssn;
    __device__ __forceinline__ void operator()(const f32x4 (&acc)[2][2][4][2], const Unit& u, int wr, int wc, int fr, int fq) const {
        const int row0 = u.pm * BM + wr * 64 + fr, col0 = u.pn * BM + wc * 32 + 8 * fq, b = (u.pm * BM) / rows_per_batch;
        const float* g = gate + (size_t)b * gate_bstride + col0;
        float ssq[2][4];
#pragma unroll
        for (int ai = 0; ai < 2; ++ai)
#pragma unroll
            for (int m = 0; m < 4; ++m) ssq[ai][m] = 0.f;
        f32x4 gv[2][2], Gv[2][2];
#pragma unroll
        for (int bj = 0; bj < 2; ++bj) { gv[bj][0] = *(const f32x4*)(g + bj * HALF); gv[bj][1] = *(const f32x4*)(g + bj * HALF + 4); Gv[bj][0] = (f32x4){0.f, 0.f, 0.f, 0.f}; Gv[bj][1] = (f32x4){0.f, 0.f, 0.f, 0.f};
            if (Hn) { const float* sc = scnext + (size_t)b * gate_bstride + col0 + bj * HALF;
                Gv[bj][0] = *(const f32x4*)(gnext + col0 + bj * HALF) * (1.0f + *(const f32x4*)(sc)); Gv[bj][1] = *(const f32x4*)(gnext + col0 + bj * HALF + 4) * (1.0f + *(const f32x4*)(sc + 4)); } }
#pragma unroll
        for (int bj = 0; bj < 2; ++bj) {
            const f32x4 g0 = gv[bj][0], g1 = gv[bj][1], G0 = Gv[bj][0], G1 = Gv[bj][1];
#pragma unroll
            for (int ai = 0; ai < 2; ++ai)
#pragma unroll
                for (int m = 0; m < 4; ++m) { const size_t off = (size_t)(row0 + ai * HALF + m * 16) * 2048 + col0 + bj * HALF;
                    f32x4 x0 = __builtin_nontemporal_load((const f32x4*)(base + off)), x1 = __builtin_nontemporal_load((const f32x4*)(base + off + 4));
                    if constexpr (HAS_DIN) { const u32x4 dw = __builtin_nontemporal_load((const u32x4*)(dbuf + off));
                        x0 += (f32x4){__builtin_bit_cast(float, dw.x << 16), __builtin_bit_cast(float, dw.x & 0xffff0000u), __builtin_bit_cast(float, dw.y << 16), __builtin_bit_cast(float, dw.y & 0xffff0000u)};
                        x1 += (f32x4){__builtin_bit_cast(float, dw.z << 16), __builtin_bit_cast(float, dw.z & 0xffff0000u), __builtin_bit_cast(float, dw.w << 16), __builtin_bit_cast(float, dw.w & 0xffff0000u)}; }
                    f32x4 o0, o1;
                    if constexpr (OUT_DELTA) { const f32x4 d0 = g0 * acc[ai][bj][m][0], d1 = g1 * acc[ai][bj][m][1];
                        u32x4 w; w.x = cvt_pk_bf16(d0[0], d0[1]); w.y = cvt_pk_bf16(d0[2], d0[3]); w.z = cvt_pk_bf16(d1[0], d1[1]); w.w = cvt_pk_bf16(d1[2], d1[3]);
                        *(u32x4*)(dbuf + off) = w;
                        o0 = x0 + (f32x4){__builtin_bit_cast(float, w.x << 16), __builtin_bit_cast(float, w.x & 0xffff0000u), __builtin_bit_cast(float, w.y << 16), __builtin_bit_cast(float, w.y & 0xffff0000u)};
                        o1 = x1 + (f32x4){__builtin_bit_cast(float, w.z << 16), __builtin_bit_cast(float, w.z & 0xffff0000u), __builtin_bit_cast(float, w.w << 16), __builtin_bit_cast(float, w.w & 0xffff0000u)}; }
                    else { o0 = x0 + g0 * acc[ai][bj][m][0]; o1 = x1 + g1 * acc[ai][bj][m][1]; *(f32x4*)(out + off) = o0; *(f32x4*)(out + off + 4) = o1; }
                    if (Hn) { const f32x4 h0 = o0 * G0, h1 = o1 * G1;
                        u32x4 w; w.x = cvt_pk_bf16(h0[0], h0[1]); w.y = cvt_pk_bf16(h0[2], h0[3]); w.z = cvt_pk_bf16(h1[0], h1[1]); w.w = cvt_pk_bf16(h1[2], h1[3]);
                        *(u32x4*)(Hn + off) = w;
                        ssq[ai][m] += ((o0[0] * o0[0] + o0[1] * o0[1]) + (o0[2] * o0[2] + o0[3] * o0[3])) + ((o1[0] * o1[0] + o1[1] * o1[1]) + (o1[2] * o1[2] + o1[3] * o1[3])); } }
            if (bj == 0) asm volatile("" ::: "memory");
        }
        if (Hn) {
#pragma unroll
            for (int ai = 0; ai < 2; ++ai)
#pragma unroll
                for (int m = 0; m < 4; ++m) { float s = ssq[ai][m]; s += __shfl_xor(s, 16); s += __shfl_xor(s, 32);
                    if (fq == 0) fx_add(ssn + row0 + ai * HALF + m * 16, s, SS_SCALE); } }
    }
};
struct EpiSwiGLU {
    static constexpr bool PERM = true, AFTER_DRAIN = false;
    bf16_t* Hd; int ldh;
    const long long* ss; const float* cvec; int cstride, rows_per_batch;
    __device__ __forceinline__ void operator()(const f32x4 (&acc)[2][2][4][2], const Unit& u, int wr, int wc, int fr, int fq) const {
        const int row0 = u.pm * BM + wr * 64 + fr, col0 = u.pn * HALF + wc * 32 + 8 * fq;
        const float* cb = cvec + (size_t)((u.pm * BM) / rows_per_batch) * cstride + u.pn * BM + wc * 32 + 8 * fq;
        long long sv[2][4];
#pragma unroll
        for (int ai = 0; ai < 2; ++ai)
#pragma unroll
            for (int m = 0; m < 4; ++m) sv[ai][m] = ss[row0 + ai * HALF + m * 16];
        f32x4 cg0 = *(const f32x4*)(cb), cg1 = *(const f32x4*)(cb + 4), cu0 = *(const f32x4*)(cb + HALF), cu1 = *(const f32x4*)(cb + HALF + 4);
        asm volatile("" : "+v"(sv[0][0]), "+v"(sv[0][1]), "+v"(sv[0][2]), "+v"(sv[0][3]), "+v"(sv[1][0]), "+v"(sv[1][1]), "+v"(sv[1][2]), "+v"(sv[1][3]), "+v"(cg0), "+v"(cg1), "+v"(cu0), "+v"(cu1));
#pragma unroll
        for (int ai = 0; ai < 2; ++ai)
#pragma unroll
            for (int m = 0; m < 4; ++m) { bf16_t* rowp = Hd + (size_t)(row0 + ai * HALF + m * 16) * ldh + col0;
                const float rstd = __builtin_amdgcn_rsqf((float)sv[ai][m] * (SS_INV * (1.0f / 2048.0f)) + RMS_EPS);
                const f32x4 ga = acc[ai][0][m][0] * rstd + cg0, gb = acc[ai][0][m][1] * rstd + cg1, ua = acc[ai][1][m][0] * rstd + cu0, ub = acc[ai][1][m][1] * rstd + cu1;
                f32x4 v0, v1;
#pragma unroll
                for (int j = 0; j < 4; ++j) { v0[j] = fsilu(ga[j]) * ua[j]; v1[j] = fsilu(gb[j]) * ub[j]; }
                u32x4 w; w.x = cvt_pk_bf16(v0[0], v0[1]); w.y = cvt_pk_bf16(v0[2], v0[3]); w.z = cvt_pk_bf16(v1[0], v1[1]); w.w = cvt_pk_bf16(v1[2], v1[3]);
                *(u32x4*)rowp = w; }
    }
};

template <class Epi, class Sched, bool ALIGN_EPI = false, bool SP2 = false>
__device__ __forceinline__ void gemm_phase(PG8_LAS unsigned char* lds, const Gemm g, const Sched& S, const Epi& E) {
    int tid_ = threadIdx.x; asm volatile("" : "+v"(tid_));
    const int tid = tid_, wid = __builtin_amdgcn_readfirstlane(tid >> 6), lane = tid & 63, wr = wid >> 2, wc = wid & 3, fr = lane & 15, fq = lane >> 4;
    const int K = g.K, nt = K / BK;
    unsigned voffA[2], voffB[2];
#pragma unroll
    for (int i = 0; i < 2; ++i) { int R, C; stage_rc(tid * 16 + i * 8192, R, C); const int Rb = Epi::PERM ? ((R & ~31) + perm32(R & 31)) : R;
        voffA[i] = (unsigned)(R * K + C) * 2u; voffB[i] = (unsigned)(Rb * K + C) * 2u; }
    const size_t kstep = (size_t)(BK * 2);
    const size_t hstep = (size_t)HALF * K * 2;
    const size_t tstep = 2 * hstep;
    const unsigned ldsw = (unsigned)wid * 1024u;
    const int aoff = lds_byte(wr * 64 + fr, fq * 8), boff = lds_byte(wc * 32 + fr, fq * 8);
#define PG8_SA(b, h) (((b) * 2 + (h)) * HTB)
#define PG8_SB(b, h) ((4 + (b) * 2 + (h)) * HTB)
#define PG8_STAGE(bufoff, gbase, voff) do { const char* gb_ = (const char*)(gbase); asm volatile("" : "+s"(gb_)); _Pragma("unroll") for (int _i = 0; _i < 2; ++_i) { unsigned vo_ = (voff)[_i]; asm volatile("" : "+v"(vo_));        \
        __builtin_amdgcn_global_load_lds((const unsigned*)(gb_ + vo_), (PG8_LAS unsigned*)(lds + (bufoff) + ldsw + _i * 8192), 16, 0, 0); } } while (0)
#define PG8_LDA(dst, b, h) do { _Pragma("unroll") for (int m = 0; m < 4; ++m) _Pragma("unroll") for (int k = 0; k < 2; ++k) dst[m][k] = *(const PG8_LAS bf16x8*)(lds + PG8_SA(b, h) + aoff + m * 2048 + k * 1024); } while (0)
#define PG8_LDB(dst, b, h) do { _Pragma("unroll") for (int n = 0; n < 2; ++n) _Pragma("unroll") for (int k = 0; k < 2; ++k) dst[n][k] = *(const PG8_LAS bf16x8*)(lds + PG8_SB(b, h) + boff + n * 2048 + k * 1024); } while (0)
#define PG8_MMA(ai, bj, At, Bt) do { __builtin_amdgcn_s_setprio(1); _Pragma("unroll") for (int m = 0; m < 4; ++m) _Pragma("unroll") for (int n = 0; n < 2; ++n) _Pragma("unroll") for (int k = 0; k < 2; ++k) \
        acc[ai][bj][m][n] = __builtin_amdgcn_mfma_f32_16x16x32_bf16(Bt[n][k], At[m][k], acc[ai][bj][m][n], 0, 0, 0); __builtin_amdgcn_s_setprio(0); } while (0)
#define PG8_WAIT_V(n) asm volatile("s_waitcnt vmcnt(" #n ")" ::: "memory")
#define PG8_WAIT_L(n) asm volatile("s_waitcnt lgkmcnt(" #n ")" ::: "memory")
#define PG8_BAR __builtin_amdgcn_s_barrier()
#define PG8_SCHED __builtin_amdgcn_sched_barrier(0)
    Unit cur, nxt; int ui = 0;
    if (!S.next(0, cur)) return;
    f32x4 acc[2][2][4][2];
#pragma unroll
    for (int a = 0; a < 2; ++a)
#pragma unroll
        for (int b = 0; b < 2; ++b)
#pragma unroll
            for (int m = 0; m < 4; ++m)
#pragma unroll
                for (int n = 0; n < 2; ++n) acc[a][b][m][n] = (f32x4){0.f, 0.f, 0.f, 0.f};
    bf16x8 At[4][2], B0[2][2], B1[2][2];
    const char* cA = (const char*)g.A + (size_t)cur.pm * tstep; const char* cB = (const char*)g.Bt + (size_t)cur.pn * tstep;
    S.a_ready(cur);
    if constexpr (SP2) {
        PG8_STAGE(PG8_SB(0, 0), cB, voffB); PG8_STAGE(PG8_SB(0, 1), cB + hstep, voffB); PG8_STAGE(PG8_SA(0, 0), cA, voffA); PG8_STAGE(PG8_SA(0, 1), cA + hstep, voffA);
        if (wr == 1) PG8_BAR;
        PG8_WAIT_V(2); PG8_BAR;
        PG8_STAGE(PG8_SB(1, 0), cB + kstep, voffB); PG8_STAGE(PG8_SA(1, 0), cA + kstep, voffA); PG8_STAGE(PG8_SB(1, 1), cB + hstep + kstep, voffB);
        PG8_WAIT_V(6); PG8_BAR;
    } else {
        PG8_STAGE(PG8_SB(0, 0), cB, voffB); PG8_STAGE(PG8_SA(0, 0), cA, voffA); PG8_STAGE(PG8_SB(0, 1), cB + hstep, voffB); PG8_STAGE(PG8_SA(0, 1), cA + hstep, voffA);
        if (wr == 1) PG8_BAR;
        PG8_WAIT_V(4); PG8_BAR;
        PG8_STAGE(PG8_SB(1, 0), cB + kstep, voffB); PG8_STAGE(PG8_SA(1, 0), cA + kstep, voffA); PG8_STAGE(PG8_SB(1, 1), cB + hstep + kstep, voffB);
        PG8_WAIT_V(6); PG8_BAR;
    }
    for (;;) {
        const bool has_next = S.next(ui + 1, nxt);
        const char* nA = has_next ? (const char*)g.A + (size_t)nxt.pm * tstep : cA; const char* nB = has_next ? (const char*)g.Bt + (size_t)nxt.pn * tstep : cB;
        for (int t = 0; t < nt; t += 2) {
            const bool last = (t == nt - 2);
            const char* a1 = cA + (size_t)(t + 1) * kstep;
            const char* a2 = last ? nA : cA + (size_t)(t + 2) * kstep; const char* b2 = last ? nB : cB + (size_t)(t + 2) * kstep;
            const char* a3 = a2 + kstep; const char* b3 = b2 + kstep;
            if (last && has_next) S.a_ready(nxt);
            if constexpr (SP2) {
            PG8_LDB(B0, 0, 0); PG8_LDB(B1, 0, 1); PG8_SCHED; PG8_LDA(At, 0, 0); PG8_STAGE(PG8_SA(1, 1), a1 + hstep, voffA);
            PG8_WAIT_V(8); PG8_WAIT_L(0); PG8_BAR; PG8_MMA(0, 0, At, B0); PG8_MMA(0, 1, At, B1); PG8_BAR; PG8_SCHED;
            PG8_LDA(At, 0, 1); PG8_STAGE(PG8_SB(0, 0), b2, voffB); PG8_STAGE(PG8_SB(0, 1), b2 + hstep, voffB); PG8_STAGE(PG8_SA(0, 0), a2, voffA);
            PG8_WAIT_V(8); PG8_WAIT_L(0); PG8_BAR; PG8_MMA(1, 0, At, B0); PG8_MMA(1, 1, At, B1); PG8_BAR; PG8_SCHED;
            PG8_LDB(B0, 1, 0); PG8_LDB(B1, 1, 1); PG8_SCHED; PG8_LDA(At, 1, 0); PG8_STAGE(PG8_SA(0, 1), a2 + hstep, voffA);
            PG8_WAIT_V(8); PG8_WAIT_L(0); PG8_BAR; PG8_MMA(0, 0, At, B0); PG8_MMA(0, 1, At, B1); PG8_BAR; PG8_SCHED;
            PG8_LDA(At, 1, 1); PG8_STAGE(PG8_SB(1, 0), b3, voffB); PG8_STAGE(PG8_SB(1, 1), b3 + hstep, voffB); PG8_STAGE(PG8_SA(1, 0), a3, voffA);
            PG8_WAIT_V(8); PG8_WAIT_L(0); PG8_BAR; PG8_MMA(1, 0, At, B0); PG8_MMA(1, 1, At, B1); PG8_BAR; PG8_SCHED;
            } else {
            PG8_LDB(B0, 0, 0); PG8_SCHED; PG8_LDA(At, 0, 0); PG8_STAGE(PG8_SA(1, 1), a1 + hstep, voffA);
            PG8_WAIT_L(8); PG8_BAR; PG8_WAIT_L(0); PG8_MMA(0, 0, At, B0); PG8_BAR; PG8_SCHED;
            PG8_LDB(B1, 0, 1); PG8_STAGE(PG8_SB(0, 0), b2, voffB);
            PG8_BAR; PG8_WAIT_L(0); PG8_MMA(0, 1, At, B1); PG8_BAR;
            PG8_LDA(At, 0, 1); PG8_STAGE(PG8_SA(0, 0), a2, voffA);
            PG8_BAR; PG8_WAIT_L(0); PG8_MMA(1, 0, At, B0); PG8_BAR; PG8_SCHED;
            PG8_STAGE(PG8_SB(0, 1), b2 + hstep, voffB);
            PG8_WAIT_V(6); PG8_BAR; PG8_MMA(1, 1, At, B1); PG8_BAR;
            PG8_LDB(B0, 1, 0); PG8_SCHED; PG8_LDA(At, 1, 0); PG8_STAGE(PG8_SA(0, 1), a2 + hstep, voffA);
            PG8_WAIT_L(8); PG8_BAR; PG8_WAIT_L(0); PG8_MMA(0, 0, At, B0); PG8_BAR; PG8_SCHED;
            PG8_LDB(B1, 1, 1); PG8_STAGE(PG8_SB(1, 0), b3, voffB);
            PG8_BAR; PG8_WAIT_L(0); PG8_MMA(0, 1, At, B1); PG8_BAR;
            PG8_LDA(At, 1, 1); PG8_STAGE(PG8_SA(1, 0), a3, voffA);
            PG8_BAR; PG8_WAIT_L(0); PG8_MMA(1, 0, At, B0); PG8_BAR; PG8_SCHED;
            PG8_STAGE(PG8_SB(1, 1), b3 + hstep, voffB);
            PG8_WAIT_V(6); PG8_BAR; PG8_MMA(1, 1, At, B1); PG8_BAR;
            }
        }
        if constexpr (ALIGN_EPI) { if (wr == 0) PG8_BAR; }
        if constexpr (!Epi::AFTER_DRAIN) { E(acc, cur, wr, wc, fr, fq); S.done(cur); }
        if (!has_next) break;
#pragma unroll
        for (int a = 0; a < 2; ++a)
#pragma unroll
            for (int b = 0; b < 2; ++b)
#pragma unroll
                for (int m = 0; m < 4; ++m)
#pragma unroll
                    for (int n = 0; n < 2; ++n) acc[a][b][m][n] = (f32x4){0.f, 0.f, 0.f, 0.f};
        cur = nxt; cA = nA; cB = nB; ++ui;
        if constexpr (ALIGN_EPI) { if (wr == 1) PG8_BAR; }
    }
    PG8_WAIT_V(0);
    if constexpr (!ALIGN_EPI) { if (wr == 0) PG8_BAR; }
    PG8_BAR;
    if constexpr (Epi::AFTER_DRAIN) { E.fused(acc, cur, wr, wc, fr, fq, lds, wid, lane); S.done(cur); }
#undef PG8_SA
#undef PG8_SB
#undef PG8_STAGE
#undef PG8_LDA
#undef PG8_LDB
#undef PG8_MMA
#undef PG8_WAIT_V
#undef PG8_WAIT_L
#undef PG8_BAR
#undef PG8_SCHED
}
}

constexpr int NWAVES = 8;
#ifndef MK_PER_PHASE
#define MK_PER_PHASE 0
#endif
constexpr int BATCH = 2, SEQ = 8192, DM = 2048, DEPTH = 4, M = BATCH * SEQ, INC = 7168, DFF = 5632, NMODC = 6 * DM;
constexpr int HGW = 1024, HD = 128, NH = 8;
constexpr float EPS = 1e-6f;
constexpr int NPL = 7;
constexpr int NPH = 3 + DEPTH * NPL;

constexpr size_t MiB = 1u << 20;
constexpr size_t WS_CTL = 0, CTL_ZERO_BYTES = 3 * MiB;
constexpr size_t WS_SS = 256 * 1024;
constexpr size_t WS_C1 = 256 * 1024 + 1024 * 1024;
constexpr size_t WS_C2 = WS_C1 + (size_t)DEPTH * BATCH * INC * 8;
static_assert(WS_C2 + (size_t)DEPTH * BATCH * 2 * DFF * 8 <= CTL_ZERO_BYTES, "accumulators inside the memset region");
constexpr size_t WS_MOD = 3 * MiB;
constexpr size_t WS_CF = 4 * MiB;
constexpr size_t WS_LB = 3 * MiB + 512 * 1024;
constexpr size_t WS_WT = 5 * MiB, WT_LAYER = 102 * MiB;
constexpr size_t WT_IN = 0, WT_OUT = 28 * MiB, WT_FI = 36 * MiB, WT_FO = 80 * MiB;
constexpr size_t WS_H = WS_WT + DEPTH * WT_LAYER;
constexpr size_t WS_P16 = WS_H + 64 * MiB;
constexpr size_t WS_MIX = WS_P16 + 256 * MiB;
constexpr size_t WS_HID = WS_MIX + 64 * MiB;
constexpr size_t WS_SLOC = WS_HID + 176 * MiB;
constexpr size_t WS_DEC = WS_SLOC + 64 * MiB;
constexpr size_t WS_XA = WS_DEC + 1 * MiB;
constexpr size_t WS_SPREV = WS_XA + 64 * MiB;
constexpr size_t WS_END = WS_SPREV + 64 * MiB;
static_assert((size_t)INC * DM * 2 == 28 * MiB && (size_t)DM * DM * 2 == 8 * MiB && (size_t)2 * DFF * DM * 2 == 44 * MiB && (size_t)DM * DFF * 2 == 22 * MiB, "weight copy sizes");
static_assert((size_t)M * DFF * 2 == 176 * MiB && (size_t)M * 8192 * 2 == 256 * MiB, "activation sizes");
constexpr int CW_TMO = 0, CW_CODE = 1;
constexpr int CW_BAR = 4096;
constexpr int CW_A1 = 8192;

constexpr int RING_OFF = 0, RING_BYTES = 131072;
constexpr int LDSCTL_OFF = RING_BYTES, MISC_OFF = LDSCTL_OFF + 320;
constexpr int LDS_BYTES = 147456;
static_assert(MISC_OFF + 128 <= LDS_BYTES, "LDS map");

#define GAS __attribute__((address_space(1)))
#define LAS __attribute__((address_space(3)))
typedef unsigned short bf16;
typedef unsigned v4u __attribute__((ext_vector_type(4)));
typedef unsigned v2u __attribute__((ext_vector_type(2)));
typedef float f32x4 __attribute__((ext_vector_type(4)));
typedef float f32x2 __attribute__((ext_vector_type(2)));
typedef GAS unsigned gu32;
typedef GAS unsigned long long gu64;
#define RLX_AGENT __ATOMIC_RELAXED, __HIP_MEMORY_SCOPE_AGENT
#define LDS_WAIT() asm volatile("s_waitcnt lgkmcnt(0)" ::: "memory")
#define VM_WAIT() asm volatile("s_waitcnt vmcnt(0)" ::: "memory")
__device__ __forceinline__ unsigned f2bf(float f) { unsigned u = __builtin_bit_cast(unsigned, f); return (u + 0x7fffu + ((u >> 16) & 1u)) >> 16; }
typedef float f32x2_t_ __attribute__((ext_vector_type(2))); typedef __bf16 bf16x2_t_ __attribute__((ext_vector_type(2)));
__device__ __forceinline__ unsigned pk2(float lo, float hi) { const f32x2_t_ v = {lo, hi}; const bf16x2_t_ b = __builtin_convertvector(v, bf16x2_t_); return __builtin_bit_cast(unsigned, b); }
__device__ __forceinline__ float bflo(unsigned w) { return __builtin_bit_cast(float, w << 16); }
__device__ __forceinline__ float bfhi(unsigned w) { return __builtin_bit_cast(float, w & 0xffff0000u); }
__device__ __forceinline__ float h2f(unsigned short hbits) { return (float)__builtin_bit_cast(_Float16, hbits); }

#define XB_TMO      128
#define XB_XCNT(j)  (256  + 64 * (j))
#define XB_XSUB(j)  (1280 + 64 * (j))
#define XB_XGEN(j)  (2304 + 64 * (j))
#define XB_TOP      3328
#define XB_TOPGEN   3392
#define XCD_BAR_WORDS 3456
#define XB_SPIN_CAP (1u << 18)

__device__ __forceinline__ unsigned xb_ld(unsigned* p)              { return __hip_atomic_load(p, __ATOMIC_RELAXED, __HIP_MEMORY_SCOPE_AGENT); }
__device__ __forceinline__ unsigned xb_add(unsigned* p, unsigned v) { return __hip_atomic_fetch_add(p, v, __ATOMIC_RELAXED, __HIP_MEMORY_SCOPE_AGENT); }
__device__ __forceinline__ unsigned xb_xcc_id() { return (unsigned)__builtin_amdgcn_s_getreg((3 << 11) | 20) & 0xFu; }
#define XB_SPIN(cond, bar) do { unsigned _sp = 0; while (cond) { __builtin_amdgcn_s_sleep(1); \
    if ((++_sp & 255u) == 0u) { if (xb_ld(&(bar)[XB_TMO])) break; if (_sp > XB_SPIN_CAP) { atomicAdd(&(bar)[XB_TMO], 1u); break; } } } } while (0)

struct XcdBarrier {
    unsigned* bar; unsigned x;
    volatile LAS unsigned* st;
};

__device__ __forceinline__ XcdBarrier xcd_barrier_post(unsigned* bar, volatile LAS unsigned* st) {
    XcdBarrier b; b.bar = bar; b.x = xb_xcc_id(); b.st = st;
    if (threadIdx.x == 0) (void)xb_add(&bar[XB_XCNT(b.x)], 1u);
    return b;
}
__device__ __forceinline__ void xcd_barrier_complete(unsigned* bar, unsigned x, unsigned& nloc, unsigned& nx) {
    const unsigned G = gridDim.x * gridDim.y * gridDim.z;
    unsigned sum, cnt, mine, sp = 0u;
    for (;;) {
        sum = 0u; cnt = 0u; mine = 0u;
#pragma unroll
        for (unsigned j = 0; j < 16; ++j) { const unsigned c = xb_ld(&bar[XB_XCNT(j)]); sum += c; cnt += (c > 0u) ? 1u : 0u; mine = (j == x) ? c : mine; }
        if (sum == G) break;
        __builtin_amdgcn_s_sleep(1);
        if ((++sp & 255u) == 0u) { if (xb_ld(&bar[XB_TMO])) break; if (sp > XB_SPIN_CAP) { atomicAdd(&bar[XB_TMO], 1u); break; } }
    }
    nloc = mine > 0u ? mine : 1u; nx = cnt > 0u ? cnt : 1u;
}

__device__ __forceinline__ void xcd_barrier(const XcdBarrier& b) {
    asm volatile("s_waitcnt vmcnt(0)" ::: "memory");
    __syncthreads();
    if (threadIdx.x == 0) {
        unsigned* bar = b.bar;
        __builtin_amdgcn_s_waitcnt(0);
        unsigned nloc = b.st[0], nx = b.st[1];
        if (nloc == 0u) { xcd_barrier_complete(bar, b.x, nloc, nx); b.st[0] = nloc; b.st[1] = nx; }
        const unsigned old = xb_add(&bar[XB_XSUB(b.x)], 1u);
        const unsigned gen = old / nloc;
        if (old + 1u == (gen + 1u) * nloc) {
            __builtin_amdgcn_fence(__ATOMIC_RELEASE, "agent");
            asm volatile("s_waitcnt vmcnt(0)" ::: "memory");
            const unsigned og = xb_add(&bar[XB_TOP], 1u);
            const unsigned tg = og / nx;
            if (og + 1u == (tg + 1u) * nx) xb_add(&bar[XB_TOPGEN], 1u);
            else XB_SPIN(xb_ld(&bar[XB_TOPGEN]) == tg, bar);
            __builtin_amdgcn_fence(__ATOMIC_ACQUIRE, "agent");
            xb_add(&bar[XB_XGEN(b.x)], 1u);
            asm volatile("s_waitcnt vmcnt(0)" ::: "memory");
        } else {
            XB_SPIN(xb_ld(&bar[XB_XGEN(b.x)]) == gen, bar);
            __builtin_amdgcn_fence(__ATOMIC_ACQUIRE, "agent");
            asm volatile("s_waitcnt vmcnt(0)" ::: "memory");
        }
    }
    __syncthreads();
}

struct Args { const float* in[15]; float* out; unsigned char* ws; int ph_lo, ph_hi, li, pad; };
struct Frame {
    LAS unsigned char* lds;
    volatile LAS unsigned* MISC;
    gu32* ctl;
    int tid, lane, wave;
    int vcu, G;
    float* out;
    unsigned char* ws;
};
#define F_x (args.in[0])
#define F_c (args.in[1])
#define F_norm1_g (args.in[2])
#define F_w_in (args.in[3])
#define F_hg_lb_logits (args.in[4])
#define F_hg_out_g (args.in[5])
#define F_sb_q_g (args.in[6])
#define F_sb_k_g (args.in[7])
#define F_sb_out_g (args.in[8])
#define F_w_out (args.in[9])
#define F_norm2_g (args.in[10])
#define F_w_ffn_in (args.in[11])
#define F_w_ffn_out (args.in[12])
#define F_w_ada (args.in[13])
#define F_b_ada (args.in[14])
#define F_MOD ((float*)(F.ws + WS_MOD))
#define F_LB ((float*)(F.ws + WS_LB))
#define F_H ((bf16*)(F.ws + WS_H))
#define F_P16 ((bf16*)(F.ws + WS_P16))
#define F_MIX ((bf16*)(F.ws + WS_MIX))
#define F_HID ((bf16*)(F.ws + WS_HID))
template <int CTRL> __device__ __forceinline__ float dpp_f(float v) { return __builtin_bit_cast(float, __builtin_amdgcn_update_dpp(0, __builtin_bit_cast(int, v), CTRL, 0xf, 0xf, false)); }
__device__ __forceinline__ float quad_sum(float v) { v += dpp_f<0xB1>(v); v += dpp_f<0x4E>(v); return v; }
__device__ __forceinline__ float row16_sum(float v) { v = quad_sum(v); v += dpp_f<0x141>(v); v += dpp_f<0x140>(v); return v; }
__device__ __forceinline__ float wave_sum(float v) {
    v = row16_sum(v);
    const int vi = __builtin_bit_cast(int, v);
    const float r0 = __builtin_bit_cast(float, __builtin_amdgcn_readlane(vi, 0)), r1 = __builtin_bit_cast(float, __builtin_amdgcn_readlane(vi, 16)), r2 = __builtin_bit_cast(float, __builtin_amdgcn_readlane(vi, 32)), r3 = __builtin_bit_cast(float, __builtin_amdgcn_readlane(vi, 48));
    return (r0 + r1) + (r2 + r3);
}

#define PHASE_FRAME(Fl) Frame Fl = F; { int t_ = F.tid; asm volatile("" : "+v"(t_)); Fl.tid = t_; Fl.lane = t_ & 63; Fl.wave = __builtin_amdgcn_readfirstlane(t_ >> 6); int v_ = F.vcu; asm volatile("" : "+s"(v_)); Fl.vcu = v_; }
__device__ __forceinline__ void transpose_item(const float* W, int K, int N, bf16* WT, int k0, int n_src0, int n_dst0, LAS float* scr, int lane, const float* sh, int sh_bstride, long long* cdst, int cstride) {
    LAS float* shl = scr + 64 * 33;
    if (sh) { shl[lane] = sh[k0 + lane]; shl[64 + lane] = sh[sh_bstride + k0 + lane]; }
#pragma unroll 8
    for (int i = 0; i < 32; ++i) { const int kk = 2 * i + (lane >> 5); scr[kk * 33 + (lane & 31)] = W[(size_t)(k0 + kk) * N + n_src0 + (lane & 31)]; }
    LDS_WAIT(); asm volatile("" ::: "memory");
    const int c = lane & 7;
#pragma unroll
    for (int j = 0; j < 4; ++j) { const int n = (lane >> 3) + 8 * j; const LAS float* s = scr + (8 * c) * 33 + n;
        v4u o; o.x = pk2(s[0 * 33], s[1 * 33]); o.y = pk2(s[2 * 33], s[3 * 33]); o.z = pk2(s[4 * 33], s[5 * 33]); o.w = pk2(s[6 * 33], s[7 * 33]);
        *(GAS v4u*)(WT + (size_t)(n_dst0 + n) * K + k0 + 8 * c) = o; }
    if (sh) { const int n = lane & 31, hf = lane >> 5; float s0 = 0.f, s1 = 0.f;
#pragma unroll 8
        for (int i = 0; i < 32; ++i) { const int kk = 32 * hf + i; const float w = scr[kk * 33 + n]; s0 += shl[kk] * w; s1 += shl[64 + kk] * w; }
        s0 += __shfl_xor(s0, 32); s1 += __shfl_xor(s1, 32);
        if (hf == 0) { pg8::fx_add(cdst + n_dst0 + n, s0, pg8::C_SCALE); pg8::fx_add(cdst + cstride + n_dst0 + n, s1, pg8::C_SCALE); } }
    LDS_WAIT(); asm volatile("" ::: "memory");
}
__device__ __forceinline__ void mod_unit(Frame& F, const Args& args, int unit) {
    const int l = unit / 48, cb = unit % 48;
    LAS float* cond = (LAS float*)(F.lds);
    LAS float* part = (LAS float*)(F.lds + 16384);
    for (int i = F.tid; i < 2 * DM; i += NWAVES * 64) { const float v = F_c[i]; cond[i] = v / (1.0f + __expf(-v)); }
    __syncthreads();
    const float* W = F_w_ada + (size_t)l * DM * NMODC + cb * 256 + F.lane * 4;
    f32x4 a0 = {0.f, 0.f, 0.f, 0.f}, a1 = {0.f, 0.f, 0.f, 0.f};
    const int kb = F.wave * 256;
#pragma unroll 32
    for (int k = 0; k < 256; ++k) { const f32x4 w = *(const GAS f32x4*)(W + (size_t)(kb + k) * NMODC); a0 += cond[kb + k] * w; a1 += cond[DM + kb + k] * w; }
    *(LAS f32x4*)(part + (F.wave * 2 + 0) * 256 + F.lane * 4) = a0;
    *(LAS f32x4*)(part + (F.wave * 2 + 1) * 256 + F.lane * 4) = a1;
    __syncthreads();
    { const int b = F.tid >> 8, col = F.tid & 255; float s = F_b_ada[l * NMODC + cb * 256 + col];
#pragma unroll
      for (int w = 0; w < 8; ++w) s += part[(w * 2 + b) * 256 + col];
      F_MOD[(size_t)(l * 2 + b) * NMODC + cb * 256 + col] = s; }
    __syncthreads();
}
__device__ __forceinline__ void lb_table(Frame& F, const Args& args) {
    for (int d = F.tid; d < HGW; d += NWAVES * 64) {
        const float x0 = F_hg_lb_logits[d], x1 = F_hg_lb_logits[HGW + d], x2 = F_hg_lb_logits[2 * HGW + d], x3 = F_hg_lb_logits[3 * HGW + d];
        const float mx = fmaxf(fmaxf(x0, x1), fmaxf(x2, x3));
        const float e0 = expf(x0 - mx), e1 = expf(x1 - mx), e2 = expf(x2 - mx), e3 = expf(x3 - mx), inv = 1.0f / (e0 + e1 + e2 + e3);
        const float p1 = e1 * inv, p2 = e2 * inv, p3 = e3 * inv;
        F_LB[d] = 0.f; F_LB[HGW + d] = p1; F_LB[2 * HGW + d] = p1 + p2; F_LB[3 * HGW + d] = (p1 + p2) + p3;
    }
}
__device__ __forceinline__ void p0_prologue_a(Frame& F, const Args& args) {
    if (F.vcu < DEPTH * 16) { const int l = F.vcu >> 4, j = F.vcu & 15; mod_unit(F, args, l * 48 + ((j < 8) ? j : 24 + (j - 8))); }
    if (F.vcu == F.G - 1) lb_table(F, args);
    __syncthreads();
    LAS float* scr = (LAS float*)(F.lds + RING_OFF + F.wave * 16384);
    const int gw = F.vcu * NWAVES + F.wave, NGW = F.G * NWAVES;
    constexpr int I_OUT = (DM / 64) * (DM / 32), I_FO = (DFF / 64) * (DM / 32), I_LAYER = I_OUT + I_FO;
    for (int it = gw; it < DEPTH * I_LAYER; it += NGW) {
        const int l = it / I_LAYER; int r = it % I_LAYER;
        unsigned char* wt = F.ws + WS_WT + (size_t)l * WT_LAYER;
        if (r < I_OUT) { const int nblk = DM / 32, kb = r / nblk, nb = r % nblk;
            transpose_item(F_w_out + (size_t)l * DM * DM, DM, DM, (bf16*)(wt + WT_OUT), 64 * kb, 32 * nb, 32 * nb, scr, F.lane, nullptr, 0, nullptr, 0); continue; } r -= I_OUT;
        { const int nblk = DM / 32, kb = r / nblk, nb = r % nblk;
            transpose_item(F_w_ffn_out + (size_t)l * DFF * DM, DFF, DM, (bf16*)(wt + WT_FO), 64 * kb, 32 * nb, 32 * nb, scr, F.lane, nullptr, 0, nullptr, 0); }
    }
}
__device__ __forceinline__ void p0_prologue_b(Frame& F, const Args& args) {
    if (F.vcu < DEPTH * 32) { const int l = F.vcu >> 5, j = F.vcu & 31; mod_unit(F, args, l * 48 + ((j < 16) ? 8 + j : 32 + (j - 16))); }
    __syncthreads();
    LAS float* scr = (LAS float*)(F.lds + RING_OFF + F.wave * 16384);
    const int gw = F.vcu * NWAVES + F.wave, NGW = F.G * NWAVES;
    constexpr int I_IN = (DM / 64) * (INC / 32), I_FI = (DM / 64) * (2 * DFF / 32), I_LAYER = I_IN + I_FI;
    for (int it = gw; it < DEPTH * I_LAYER; it += NGW) {
        const int l = it / I_LAYER; int r = it % I_LAYER;
        unsigned char* wt = F.ws + WS_WT + (size_t)l * WT_LAYER;
        const float* modl = F_MOD + (size_t)l * 2 * NMODC;
        if (r < I_IN) { const int nblk = INC / 32, kb = r / nblk, nb = r % nblk;
            transpose_item(F_w_in + (size_t)l * DM * INC, DM, INC, (bf16*)(wt + WT_IN), 64 * kb, 32 * nb, 32 * nb, scr, F.lane, modl, NMODC, (long long*)(F.ws + WS_C1) + (size_t)l * BATCH * INC, INC); continue; } r -= I_IN;
        { const int nblk = 2 * DFF / 32, kb = r / nblk, nb = r % nblk, p = nb >> 3, q = nb & 7;
            const int nsrc = (q < 4) ? (128 * p + 32 * q) : (DFF + 128 * p + 32 * (q - 4));
            transpose_item(F_w_ffn_in + (size_t)l * DM * 2 * DFF, DM, 2 * DFF, (bf16*)(wt + WT_FI), 64 * kb, nsrc, 32 * nb, scr, F.lane, modl + 3 * DM, NMODC, (long long*)(F.ws + WS_C2) + (size_t)l * BATCH * 2 * DFF, 2 * DFF); }
    }
}
__device__ __forceinline__ void norm0_phase(Frame& F, const float* x, const float* g, const float* modl, int sc_off, long long* ss) {
    const int gw = F.vcu * NWAVES + F.wave, NGW = F.G * NWAVES;
    for (int row = gw; row < M; row += NGW) {
        const float* mb = modl + (size_t)(row / SEQ) * NMODC;
        const GAS f32x4* xr = (const GAS f32x4*)(x + (size_t)row * DM) + F.lane;
        f32x4 v[8]; float s = 0.f;
#pragma unroll
        for (int j = 0; j < 8; ++j) { v[j] = xr[64 * j]; s += (v[j].x * v[j].x + v[j].y * v[j].y) + (v[j].z * v[j].z + v[j].w * v[j].w); }
        s = wave_sum(s);
        if (F.lane == 0) ss[row] = __float2ll_rn(s * pg8::SS_SCALE);
        GAS v2u* o8 = (GAS v2u*)(F_H + (size_t)row * DM) + F.lane;
#pragma unroll
        for (int j = 0; j < 8; ++j) { const int col = 4 * F.lane + 256 * j;
            const f32x4 gg = *(const GAS f32x4*)(g + col), sc = *(const GAS f32x4*)(mb + sc_off + col);
            const f32x4 y = v[j] * gg * (1.0f + sc);
            v2u w; w.x = pk2(y.x, y.y); w.y = pk2(y.z, y.w); o8[64 * j] = w; }
    }
}

typedef short bf16x8 __attribute__((ext_vector_type(8)));
constexpr int P16S = pg8::P16_LD;
constexpr int TS = 136;
constexpr int VS = 72;
constexpr int VR = 144;
constexpr int HG_UNITS = BATCH * NH * (SEQ / 64);
typedef short s16x4 __attribute__((ext_vector_type(4)));
__device__ __forceinline__ bf16x8 tr_frag(const LAS unsigned short* p0, const LAS unsigned short* p1) {
    const s16x4 a = __builtin_bit_cast(s16x4, __builtin_amdgcn_ds_read_tr16_b64_v4i16((LAS s16x4*)p0)), b = __builtin_bit_cast(s16x4, __builtin_amdgcn_ds_read_tr16_b64_v4i16((LAS s16x4*)p1));
    return (bf16x8){a[0], a[1], a[2], a[3], b[0], b[1], b[2], b[3]};
}
#define LDS_BARRIER() do { asm volatile("s_waitcnt lgkmcnt(0)" ::: "memory"); __builtin_amdgcn_s_barrier(); asm volatile("" ::: "memory"); } while (0)
#define MFMA16(X, Y, C) __builtin_amdgcn_mfma_f32_16x16x32_bf16((X), (Y), (C), 0, 0, 0)


struct HgRegs { unsigned lf[8], q[8]; v4u v[2]; };
template <bool WANT_Q> __device__ __forceinline__ void hg_issue(Frame& F, HgRegs& R, int u) {
    const int bh = u >> 7, c = u & 127, b = bh >> 3, h = bh & 7, dp = F.tid & 63, grp = F.tid >> 6;
    const bf16* P = F_P16 + (size_t)(b * SEQ + 64 * c) * P16S + h * HD;
#pragma unroll
    for (int j = 0; j < 8; ++j) { const bf16* src = P + (size_t)(8 * grp + j) * P16S + 2 * dp;
        if (WANT_Q) { R.lf[j] = __builtin_nontemporal_load((const GAS unsigned*)(src + 1024)); R.q[j] = __builtin_nontemporal_load((const GAS unsigned*)(src)); }
        else R.lf[j] = *(const GAS unsigned*)(src + 1024); }
#pragma unroll
    for (int i = 0; i < 2; ++i) { const int ch = F.tid + 512 * i, r = ch >> 4, cc = ch & 15; const GAS v4u* vp_ = (const GAS v4u*)(P + (size_t)r * P16S + 2048 + cc * 8); R.v[i] = WANT_Q ? __builtin_nontemporal_load(vp_) : *vp_; }
}
__device__ __forceinline__ void hgrn2_a1_all(Frame& F) {
    constexpr int SET = 64 * VR * 2 + 8 * 128 * 2;
    const int dp = F.tid & 63, grp = F.tid >> 6, g = F.lane >> 4, li = F.lane & 15;
    HgRegs R; int u = F.vcu, par = 0;
    if (u < HG_UNITS) hg_issue<false>(F, R, u);
    while (u < HG_UNITS) {
        LAS unsigned short* Lk = (LAS unsigned short*)(F.lds) + par * SET;
        LAS unsigned short* Lv = Lk + 64 * VR;
        LAS float* Ltot = (LAS float*)(Lv + 64 * VR);
        float bl0[8], bl1[8]; { float r0 = 0.f, r1 = 0.f;
#pragma unroll
            for (int j = 0; j < 8; ++j) { r0 += h2f((unsigned short)(R.lf[j] & 0xffffu)); r1 += h2f((unsigned short)(R.lf[j] >> 16)); bl0[j] = r0; bl1[j] = r1; }
            *(LAS f32x2*)(Ltot + grp * 128 + 2 * dp) = (f32x2){r0, r1}; }
#pragma unroll
        for (int i = 0; i < 2; ++i) { const int ch = F.tid + 512 * i, r = ch >> 4, cc = ch & 15; *(LAS v4u*)(Lv + r * VR + cc * 8) = R.v[i]; }
        LDS_BARRIER();
        { float off0 = 0.f, off1 = 0.f, tot0 = 0.f, tot1 = 0.f;
#pragma unroll
          for (int gg = 0; gg < 8; ++gg) { const f32x2 t = *(const LAS f32x2*)(Ltot + gg * 128 + 2 * dp); if (gg < grp) { off0 += t.x; off1 += t.y; } tot0 += t.x; tot1 += t.y; }
#pragma unroll
          for (int j = 0; j < 8; ++j) { const float k0 = 1.0f - __expf(h2f((unsigned short)(R.lf[j] & 0xffffu))), k1 = 1.0f - __expf(h2f((unsigned short)(R.lf[j] >> 16)));
              *(LAS unsigned*)(Lk + (8 * grp + j) * VR + 2 * dp) = pk2(k0 * __expf(tot0 - (bl0[j] + off0)), k1 * __expf(tot1 - (bl1[j] + off1))); }
          if (grp == 0) *(GAS f32x2*)((float*)(F.ws + WS_DEC) + (size_t)u * 128 + 2 * dp) = (f32x2){__expf(tot0), __expf(tot1)}; }
        LDS_BARRIER();
        const int un = u + F.G;
        if (un < HG_UNITS) hg_issue<false>(F, R, un);
        { const LAS unsigned short* xb = Lk + (4 * g + (li >> 2)) * VR + 16 * F.wave + 4 * (li & 3);
          const LAS unsigned short* yb = Lv + (4 * g + (li >> 2)) * VR + 4 * (li & 3);
          const bf16x8 X0 = tr_frag(xb, xb + 16 * VR), X1 = tr_frag(xb + 32 * VR, xb + 48 * VR);
          bf16* so = (bf16*)(F.ws + WS_SLOC) + (size_t)u * 16384 + 16 * F.wave + 4 * g;
#pragma unroll
          for (int eb = 0; eb < 8; ++eb) { const bf16x8 Y0 = tr_frag(yb + 16 * eb, yb + 16 * eb + 16 * VR), Y1 = tr_frag(yb + 16 * eb + 32 * VR, yb + 16 * eb + 48 * VR);
              f32x4 acc = {0.f, 0.f, 0.f, 0.f}; acc = MFMA16(X0, Y0, acc); acc = MFMA16(X1, Y1, acc);
              v2u w; w.x = pk2(acc[0], acc[1]); w.y = pk2(acc[2], acc[3]);
              *(GAS v2u*)(so + (size_t)(16 * eb + li) * 128) = w; } }
        u = un; par ^= 1;
    }
    LDS_BARRIER();
}
__device__ __forceinline__ void hgrn2_a2(Frame& F) {
    const int NGW = F.G * NWAVES;
    for (int row = F.vcu * NWAVES + F.wave; row < BATCH * NH * 128; row += NGW) {
        const int bh = row >> 7, e = row & 127;
        const GAS unsigned* base = (const GAS unsigned*)(F.ws + WS_SLOC) + ((size_t)bh * 128 * 128 + e) * 64 + F.lane;
        GAS unsigned* obase = (GAS unsigned*)(F.ws + WS_SPREV) + ((size_t)bh * 128 * 128 + e) * 64 + F.lane;
        const GAS f32x2* dbase = (const GAS f32x2*)(F.ws + WS_DEC) + (size_t)bh * 128 * 64 + F.lane;
        float S0 = 0.f, S1 = 0.f;
        for (int c0 = 0; c0 < 128; c0 += 32) {
            unsigned loc[32]; f32x2 dc[32];
#pragma unroll
            for (int j = 0; j < 32; ++j) { loc[j] = __builtin_nontemporal_load(base + (size_t)(c0 + j) * 8192); dc[j] = dbase[(c0 + j) * 64]; }
#pragma unroll
            for (int j = 0; j < 32; ++j) { obase[(size_t)(c0 + j) * 8192] = pk2(S0, S1); S0 = dc[j].x * S0 + bflo(loc[j]); S1 = dc[j].y * S1 + bfhi(loc[j]); }
        }
    }
}

__device__ __forceinline__ void hgrn2_a3_all(Frame& F, const Args& args, int layer) {
    LAS unsigned short* Lq = (LAS unsigned short*)(F.lds);
    LAS unsigned short* Lk = Lq + 64 * TS;
    LAS unsigned short* Li = Lk + 64 * TS;
    LAS unsigned short* Lv = Li + 64 * TS;
    LAS unsigned short* LP = Lv + 64 * VR;
    LAS float* Lo = (LAS float*)(LP + 64 * VS);
    LAS float* Ltot = Lo + 64 * 132;
    const int dp = F.tid & 63, grp = F.tid >> 6, g = F.lane >> 4, li = F.lane & 15;
    HgRegs R; bf16x8 Spn[4]; unsigned gate[8]; f32x2 ogn; int u = F.vcu;
#define A3_ISSUE(uu) do { hg_issue<true>(F, R, (uu)); const int bh_ = (uu) >> 7, c_ = (uu) & 127; \
        const bf16* sp_ = (const bf16*)(F.ws + WS_SPREV) + (size_t)(uu) * 16384 + (size_t)(16 * F.wave + li) * 128 + 8 * g; \
        _Pragma("unroll") for (int kd = 0; kd < 4; ++kd) Spn[kd] = __builtin_nontemporal_load((const GAS bf16x8*)(sp_ + 32 * kd)); \
        const bf16* gp_ = F_P16 + (size_t)((bh_ >> 3) * SEQ + 64 * c_ + 8 * F.wave) * P16S + 3072 + (bh_ & 7) * HD + 2 * F.lane; \
        _Pragma("unroll") for (int rr = 0; rr < 8; ++rr) gate[rr] = __builtin_nontemporal_load((const GAS unsigned*)(gp_ + (size_t)rr * P16S)); \
        ogn = *(const GAS f32x2*)(F_hg_out_g + layer * HGW + (bh_ & 7) * HD + 2 * F.lane); } while (0)
    if (u < HG_UNITS) A3_ISSUE(u);
    while (u < HG_UNITS) {
        const int bh = u >> 7, c = u & 127, b = bh >> 3, h = bh & 7;
        const size_t row0 = (size_t)(b * SEQ + 64 * c);
        float bl0[8], bl1[8]; { float r0 = 0.f, r1 = 0.f;
#pragma unroll
            for (int j = 0; j < 8; ++j) { r0 += h2f((unsigned short)(R.lf[j] & 0xffffu)); r1 += h2f((unsigned short)(R.lf[j] >> 16)); bl0[j] = r0; bl1[j] = r1; }
            *(LAS f32x2*)(Ltot + grp * 128 + 2 * dp) = (f32x2){r0, r1}; }
#pragma unroll
        for (int i = 0; i < 2; ++i) { const int ch = F.tid + 512 * i, r = ch >> 4, cc = ch & 15; *(LAS v4u*)(Lv + r * VR + cc * 8) = R.v[i]; }
        LDS_BARRIER();
        { float off0 = 0.f, off1 = 0.f, ref0 = 0.f, ref1 = 0.f;
#pragma unroll
          for (int gg = 0; gg < 7; ++gg) { const f32x2 t = *(const LAS f32x2*)(Ltot + gg * 128 + 2 * dp); if (gg < grp) { off0 += t.x; off1 += t.y; } if (gg < 4) { ref0 += t.x; ref1 += t.y; } }
#pragma unroll
          for (int j = 0; j < 8; ++j) { const int s = 8 * grp + j; const float b0 = bl0[j] + off0, b1 = bl1[j] + off1; const float q0 = bflo(R.q[j]), q1 = bfhi(R.q[j]);
              *(LAS unsigned*)(Lq + s * TS + 2 * dp) = pk2(q0 * __expf(fminf(b0 - ref0, 80.f)), q1 * __expf(fminf(b1 - ref1, 80.f)));
              const float k0 = 1.0f - __expf(h2f((unsigned short)(R.lf[j] & 0xffffu))), k1 = 1.0f - __expf(h2f((unsigned short)(R.lf[j] >> 16)));
              *(LAS unsigned*)(Lk + s * TS + 2 * dp) = pk2(k0 * __expf(fminf(ref0 - b0, 80.f)), k1 * __expf(fminf(ref1 - b1, 80.f)));
              *(LAS unsigned*)(Li + s * TS + 2 * dp) = pk2(q0 * __expf(b0), q1 * __expf(b1)); } }
        bf16x8 Sp[4]; unsigned gw[8];
#pragma unroll
        for (int kd = 0; kd < 4; ++kd) Sp[kd] = Spn[kd];
#pragma unroll
        for (int rr = 0; rr < 8; ++rr) gw[rr] = gate[rr];
        const f32x2 og = ogn;
        LDS_BARRIER();
        const int un = u + F.G;
        if (un < HG_UNITS) A3_ISSUE(un);
#pragma unroll
        for (int k2 = 0; k2 < 2; ++k2) { const int id = 2 * F.wave + k2, si = id >> 2, ti = id & 3;
            f32x4 acc = {0.f, 0.f, 0.f, 0.f};
            if (si <= ti) {
#pragma unroll
                for (int kd = 0; kd < 4; ++kd) { const bf16x8 X = *(const LAS bf16x8*)(Lk + (16 * si + li) * TS + 32 * kd + 8 * g), Y = *(const LAS bf16x8*)(Lq + (16 * ti + li) * TS + 32 * kd + 8 * g);
                    acc = MFMA16(X, Y, acc); }
                const int t = 16 * ti + li, s0 = 16 * si + 4 * g;
#pragma unroll
                for (int r = 0; r < 4; ++r) acc[r] = (s0 + r <= t) ? acc[r] : 0.f; }
            v2u w; w.x = pk2(acc[0], acc[1]); w.y = pk2(acc[2], acc[3]);
            *(LAS v2u*)(LP + (16 * ti + li) * VS + 16 * si + 4 * g) = w; }
        LDS_BARRIER();
        { f32x4 acc[4];
#pragma unroll
          for (int ti = 0; ti < 4; ++ti) acc[ti] = (f32x4){0.f, 0.f, 0.f, 0.f};
          const LAS unsigned short* yb = Lv + (4 * g + (li >> 2)) * VR + 16 * F.wave + 4 * (li & 3);
#pragma unroll
          for (int ks = 0; ks < 2; ++ks) { const bf16x8 Y = tr_frag(yb + 32 * ks * VR, yb + (32 * ks + 16) * VR);
#pragma unroll
              for (int ti = 0; ti < 4; ++ti) { const LAS unsigned short* pp = LP + (16 * ti + li) * VS + 32 * ks + 4 * g; const v2u x0 = *(const LAS v2u*)(pp), x1 = *(const LAS v2u*)(pp + 16);
                  acc[ti] = MFMA16(__builtin_bit_cast(bf16x8, (v4u){x0.x, x0.y, x1.x, x1.y}), Y, acc[ti]); } }
#pragma unroll
          for (int kd = 0; kd < 4; ++kd) {
#pragma unroll
              for (int ti = 0; ti < 4; ++ti) { const bf16x8 X = *(const LAS bf16x8*)(Li + (16 * ti + li) * TS + 32 * kd + 8 * g); acc[ti] = MFMA16(X, Sp[kd], acc[ti]); } }
#pragma unroll
          for (int ti = 0; ti < 4; ++ti)
#pragma unroll
              for (int r = 0; r < 4; ++r) Lo[(16 * ti + 4 * g + r) * 132 + 16 * F.wave + li] = acc[ti][r]; }
        LDS_BARRIER();
        {
#pragma unroll
          for (int rr = 0; rr < 8; ++rr) { const int t = 8 * F.wave + rr; const size_t row = row0 + t;
              const f32x2 o = *(const LAS f32x2*)(Lo + t * 132 + 2 * F.lane);
              const float rstd = __builtin_amdgcn_rsqf(wave_sum(o.x * o.x + o.y * o.y) * (1.0f / HD) + EPS);
              *(GAS unsigned*)(F_MIX + row * DM + h * HD + 2 * F.lane) = pk2(o.x * rstd * og.x * bflo(gw[rr]), o.y * rstd * og.y * bfhi(gw[rr])); } }
        u = un;
    }
    LDS_BARRIER();
#undef A3_ISSUE
}

constexpr int AT_UNITS = BATCH * NH * (SEQ / 128);
constexpr float AT_STOP = 7.888609052210118e-31f;
struct AtRegs { v4u k[4], v[4]; };
__device__ __forceinline__ void at_issue(AtRegs& R, const bf16* Pb, int kb, int lr, int lc) {
#pragma unroll
    for (int i = 0; i < 4; ++i) { const bf16* src = Pb + (size_t)(128 * kb + lr + 32 * i) * P16S + lc * 8; R.k[i] = *(const GAS v4u*)(src + 5120); R.v[i] = *(const GAS v4u*)(src + 6144); }
}
__device__ __forceinline__ void at_half(Frame& F, int kb64, int hb, int tw, const LAS unsigned short* LKh, const LAS unsigned short* LVh, const bf16x8 (&Qf)[4], f32x4 (&O)[8], float& run) {
    const int g = F.lane >> 4, li = F.lane & 15, t = tw + li; const int kb = kb64; const LAS unsigned short* LK = LKh; const LAS unsigned short* LV = LVh;
    {
        float kp[4][4], sg[4][4];
#pragma unroll
        for (int sb = 0; sb < 4; ++sb) { f32x4 acc = {0.f, 0.f, 0.f, 0.f};
#pragma unroll
            for (int kd = 0; kd < 4; ++kd) { const bf16x8 X = *(const LAS bf16x8*)(LK + (16 * sb + li) * TS + 32 * kd + 8 * g); acc = MFMA16(X, Qf[kd], acc); }
#pragma unroll
            for (int r = 0; r < 4; ++r) { const float w = __builtin_amdgcn_exp2f(acc[r]); const float keep = __builtin_amdgcn_rcpf(1.0f + w);
                const bool valid = (64 * kb + 16 * sb + 4 * g + r) < t;
                kp[sb][r] = valid ? keep : 1.0f; sg[sb][r] = 1.0f - kp[sb][r]; } }
        float excl[4], TT[4], e1[4], e0[4];
#pragma unroll
        for (int sb = 0; sb < 4; ++sb) { e1[sb] = kp[sb][3] * kp[sb][2]; e0[sb] = e1[sb] * kp[sb][1]; const float T = e0[sb] * kp[sb][0];
            const float x1 = __shfl(T, (F.lane + 16) & 63), x2 = __shfl(T, (F.lane + 32) & 63), x3 = __shfl(T, (F.lane + 48) & 63);
            excl[sb] = (((g < 3) ? x1 : 1.0f) * ((g < 2) ? x2 : 1.0f)) * ((g < 1) ? x3 : 1.0f);
            TT[sb] = (T * ((g & 1) ? x3 : x1)) * (x2 * ((g & 1) ? x1 : x3)); }
        float off = run; bf16x8 X[2];
        { unsigned p[8];
#pragma unroll
          for (int sb = 3; sb >= 0; --sb) { const float base = off * excl[sb]; off *= TT[sb];
              const float a3 = base * sg[sb][3], a2 = base * kp[sb][3] * sg[sb][2], a1 = base * e1[sb] * sg[sb][1], a0 = base * e0[sb] * sg[sb][0];
              p[2 * sb] = pk2(a0, a1); p[2 * sb + 1] = pk2(a2, a3); }
          X[0] = __builtin_bit_cast(bf16x8, (v4u){p[0], p[1], p[2], p[3]}); X[1] = __builtin_bit_cast(bf16x8, (v4u){p[4], p[5], p[6], p[7]}); }
        run = off;
#pragma unroll
        for (int eb = 0; eb < 8; ++eb)
#pragma unroll
            for (int ks = 0; ks < 2; ++ks) { const LAS unsigned short* vp = LV + (32 * ks + 4 * g + (li >> 2)) * VR + 16 * eb + 4 * (li & 3);
                O[eb] = MFMA16(X[ks], tr_frag(vp, vp + 16 * VR), O[eb]); }
    }
}
__device__ __forceinline__ bool at_stage(Frame& F, AtRegs& R, const bf16* Pb, int kb, int tw, int lr, int lc, LAS unsigned short* LK, LAS unsigned short* LV, LAS unsigned* Lflag,
                                         const bf16x8 (&Qf)[4], f32x4 (&O)[8], float& run, bool& wdone, bool issue_next, AtRegs& Rn, v4u (&qn)[4], const bf16* Pbn, int tn, int qtn) {
    LDS_BARRIER();
    { unsigned all = 1u;
#pragma unroll
      for (int w = 0; w < 8; ++w) all &= Lflag[w];
      if (__builtin_amdgcn_readfirstlane(all)) return true; }
#pragma unroll
    for (int i = 0; i < 4; ++i) { const int r = lr + 32 * i; const unsigned ka[4] = {R.k[i].x, R.k[i].y, R.k[i].z, R.k[i].w}; float kv[8]; float ss = 0.f;
#pragma unroll
        for (int j = 0; j < 4; ++j) { kv[2 * j] = bflo(ka[j]); kv[2 * j + 1] = bfhi(ka[j]); ss += kv[2 * j] * kv[2 * j] + kv[2 * j + 1] * kv[2 * j + 1]; }
        ss = row16_sum(ss);
        const float rk = __builtin_amdgcn_rsqf(ss * (1.0f / HD) + EPS);
        *(LAS v4u*)(LK + r * TS + lc * 8) = (v4u){pk2(kv[0] * rk, kv[1] * rk), pk2(kv[2] * rk, kv[3] * rk), pk2(kv[4] * rk, kv[5] * rk), pk2(kv[6] * rk, kv[7] * rk)};
        *(LAS v4u*)(LV + r * VR + lc * 8) = R.v[i]; }
    LDS_BARRIER();
    at_issue(R, Pb, (kb >= 1) ? (kb - 1) : 0, lr, lc);
    if (issue_next) {
        const int g_ = F.lane >> 4;
#pragma unroll
        for (int kd = 0; kd < 4; ++kd) qn[kd] = *(const GAS v4u*)(Pbn + (size_t)tn * P16S + 4096 + 32 * kd + 8 * g_);
        at_issue(Rn, Pbn, qtn, lr, lc); }
    if (!wdone && (128 * kb + 64 <= tw + 14)) { at_half(F, 2 * kb + 1, 1, tw, LK + 64 * TS, LV + 64 * VR, Qf, O, run); wdone = __all(run < AT_STOP); }
    if (!wdone && (128 * kb <= tw + 14)) { at_half(F, 2 * kb, 0, tw, LK, LV, Qf, O, run); wdone = __all(run < AT_STOP); }
    if (kb == 0) wdone = true;
    if (wdone && F.lane == 0) Lflag[F.wave] = 1u;
    return false;
}
__device__ __forceinline__ void attn_all(Frame& F, const Args& args, int layer) {
    LAS unsigned short* LK = (LAS unsigned short*)(F.lds);
    LAS unsigned short* LV = LK + 128 * TS;
    LAS unsigned* Lflag = (LAS unsigned*)(LV + 128 * VR);
    LAS float* Lo = (LAS float*)(F.lds) + F.wave * (16 * 132);
    const int g = F.lane >> 4, li = F.lane & 15, lr = F.tid >> 4, lc = F.tid & 15;
    LAS float* Lgqk = (LAS float*)(Lflag + 16); LAS float* Log = Lgqk + 128;
    if (F.tid < 128) Lgqk[F.tid] = F_sb_q_g[layer * HD + F.tid] * F_sb_k_g[layer * HD + F.tid] * (0.08838834764831845f * 1.4426950408889634f);
    for (int i = F.tid; i < HGW; i += NWAVES * 64) Log[i] = F_sb_out_g[layer * HGW + i];
    LDS_BARRIER();
    AtRegs R0, Rn; v4u qraw[4], qn[4];
    int u = F.vcu;
    if (u < AT_UNITS) { const int bh_ = u >> 6, qt_ = u & 63; const bf16* Pb_ = F_P16 + (size_t)((bh_ >> 3) * SEQ) * P16S + (bh_ & 7) * HD; const int t_ = 128 * qt_ + 16 * F.wave + li;
#pragma unroll
        for (int kd = 0; kd < 4; ++kd) qraw[kd] = *(const GAS v4u*)(Pb_ + (size_t)t_ * P16S + 4096 + 32 * kd + 8 * g);
        at_issue(R0, Pb_, qt_, lr, lc); }
    while (u < AT_UNITS) {
        const int bh = u >> 6, qt = u & 63, b = bh >> 3, h = bh & 7, t0 = 128 * qt, tw = t0 + 16 * F.wave;
        const bf16* Pb = F_P16 + (size_t)(b * SEQ) * P16S + h * HD;
        const int un = u + F.G; const bool has_next = un < AT_UNITS;
        const int bhn = has_next ? (un >> 6) : bh, qtn = has_next ? (un & 63) : qt; const bf16* Pbn = F_P16 + (size_t)((bhn >> 3) * SEQ) * P16S + (bhn & 7) * HD; const int tn = 128 * qtn + 16 * F.wave + li;
        bf16x8 Qf[4];
        { float qv[32]; float ss = 0.f;
#pragma unroll
          for (int kd = 0; kd < 4; ++kd) { const unsigned a[4] = {qraw[kd].x, qraw[kd].y, qraw[kd].z, qraw[kd].w};
#pragma unroll
              for (int j = 0; j < 4; ++j) { const float lo = bflo(a[j]), hi = bfhi(a[j]); qv[8 * kd + 2 * j] = lo; qv[8 * kd + 2 * j + 1] = hi; ss += lo * lo + hi * hi; } }
          ss += __shfl_xor(ss, 16); ss += __shfl_xor(ss, 32);
          const float rq = __builtin_amdgcn_rsqf(ss * (1.0f / HD) + EPS);
#pragma unroll
          for (int kd = 0; kd < 4; ++kd) { unsigned p[4];
              const f32x4 c0 = *(const LAS f32x4*)(Lgqk + 32 * kd + 8 * g), c1 = *(const LAS f32x4*)(Lgqk + 32 * kd + 8 * g + 4); const float cc[8] = {c0.x, c0.y, c0.z, c0.w, c1.x, c1.y, c1.z, c1.w};
#pragma unroll
              for (int j = 0; j < 4; ++j) p[j] = pk2(qv[8 * kd + 2 * j] * rq * cc[2 * j], qv[8 * kd + 2 * j + 1] * rq * cc[2 * j + 1]);
              Qf[kd] = __builtin_bit_cast(bf16x8, (v4u){p[0], p[1], p[2], p[3]}); } }
        float run = 1.0f;
        f32x4 O[8];
#pragma unroll
        for (int eb = 0; eb < 8; ++eb) O[eb] = (f32x4){0.f, 0.f, 0.f, 0.f};
        bool wdone = false, issued = false;
        if (F.tid < 8) Lflag[F.tid] = 0u;
        for (int kb = qt; kb >= 0; --kb) {
            const bool inow = has_next && !issued && (kb == qt - 1 || kb == 0);
            if (at_stage(F, R0, Pb, kb, tw, lr, lc, LK, LV, Lflag, Qf, O, run, wdone, inow, Rn, qn, Pbn, tn, qtn)) break;
            issued = issued || inow;
        }
        LDS_BARRIER();
        if (has_next && !issued) {
#pragma unroll
            for (int kd = 0; kd < 4; ++kd) qn[kd] = *(const GAS v4u*)(Pbn + (size_t)tn * P16S + 4096 + 32 * kd + 8 * g);
            at_issue(Rn, Pbn, qtn, lr, lc); }
#pragma unroll
        for (int eb = 0; eb < 8; ++eb)
#pragma unroll
            for (int r = 0; r < 4; ++r) Lo[(4 * g + r) * 132 + 16 * eb + li] = O[eb][r];
        LDS_WAIT(); asm volatile("" ::: "memory");
        { const int rr = F.lane >> 2, es = 32 * (F.lane & 3); f32x4 ov[8]; float ss = 0.f;
#pragma unroll
          for (int i = 0; i < 8; ++i) { ov[i] = *(const LAS f32x4*)(Lo + rr * 132 + es + 4 * i); ss += (ov[i].x * ov[i].x + ov[i].y * ov[i].y) + (ov[i].z * ov[i].z + ov[i].w * ov[i].w); }
          ss = quad_sum(ss);
          const float ro = __builtin_amdgcn_rsqf(ss * (1.0f / HD) + EPS);
          GAS v4u* op = (GAS v4u*)(F_MIX + (size_t)(b * SEQ + tw + rr) * DM + HGW + h * HD + es);
#pragma unroll
          for (int i = 0; i < 4; ++i) { const f32x4 a0 = ov[2 * i] * ro * *(const LAS f32x4*)(Log + h * HD + es + 8 * i), a1 = ov[2 * i + 1] * ro * *(const LAS f32x4*)(Log + h * HD + es + 8 * i + 4);
              op[i] = (v4u){pk2(a0.x, a0.y), pk2(a0.z, a0.w), pk2(a1.x, a1.y), pk2(a1.z, a1.w)}; } }
        LDS_BARRIER();
#pragma unroll
        for (int kd = 0; kd < 4; ++kd) qraw[kd] = qn[kd];
        R0 = Rn;
        u = un;
    }
}
__global__ void __launch_bounds__(NWAVES * 64, 2) skel_fwd(Args args) {
    extern __shared__ __attribute__((aligned(16))) unsigned char lds[];
    Frame F;
    F.lds = (LAS unsigned char*)lds;
    F.MISC = (volatile LAS unsigned*)(F.lds + MISC_OFF);
    F.tid = threadIdx.x; F.lane = F.tid & 63; F.wave = __builtin_amdgcn_readfirstlane(F.tid >> 6);
    F.G = gridDim.x; { const int bx = blockIdx.x; F.vcu = (F.G % 8 == 0) ? (bx % 8) * (F.G / 8) + bx / 8 : bx; }
    unsigned char* ws = args.ws; F.ws = ws; F.out = args.out;
    F.ctl = (gu32*)(ws + WS_CTL);
    for (int u = F.tid; u < (LDS_BYTES - LDSCTL_OFF) / 4; u += NWAVES * 64) ((LAS unsigned*)(F.lds + LDSCTL_OFF))[u] = 0u;
    __syncthreads();
    XcdBarrier bar; bar.bar = (unsigned*)(F.ctl + CW_BAR); bar.x = 0; bar.st = nullptr;
    if (!MK_PER_PHASE) bar = xcd_barrier_post((unsigned*)(F.ctl + CW_BAR), F.MISC + 8);
#define GRID_BAR(seam) do { if (MK_PER_PHASE) { if (F.tid == 0) __hip_atomic_store(F.ctl + CW_TMO, 0xBADBA0u | (unsigned)(seam), RLX_AGENT); } else { XcdBarrier b_ = bar; unsigned* p_ = b_.bar; asm volatile("" : "+s"(p_)); b_.bar = p_; xcd_barrier(b_); } } while (0)
    const int lo = args.ph_lo, hi = args.ph_hi;
#define IN(k) (lo <= (k) && (k) < hi)
#define BOTH(k) (IN(k) && IN((k) + 1))

    if (IN(0)) { PHASE_FRAME(Fl); p0_prologue_a(Fl, args); if (BOTH(0)) GRID_BAR(0); }
    if (IN(1)) { PHASE_FRAME(Fl); p0_prologue_b(Fl, args); if (BOTH(1)) GRID_BAR(1); }
    if (IN(2)) { PHASE_FRAME(Fl); norm0_phase(Fl, F_x, F_norm1_g, F_MOD, DM, (long long*)(ws + WS_SS));
        { constexpr int NC = DEPTH * BATCH * (INC + 2 * DFF); const long long* cfx = (const long long*)(ws + WS_C1); float* cf = (float*)(ws + WS_CF);
          for (int i = Fl.vcu * (NWAVES * 64) + Fl.tid; i < NC; i += Fl.G * NWAVES * 64) cf[i] = pg8::fx_get(cfx + i, pg8::C_INV); }
        if (BOTH(2)) GRID_BAR(2); }

    for (int l = 0; l < DEPTH; ++l) {
        const int p0 = 3 + NPL * l;
        const float* xin = (l == 0) ? F_x : F.out;
        bf16* xa = (bf16*)(ws + WS_XA);
        const float* modl = F_MOD + (size_t)l * 2 * NMODC;
        const unsigned char* wt = ws + WS_WT + (size_t)l * WT_LAYER;
        long long* ss1 = (long long*)(ws + WS_SS) + (size_t)(2 * l) * M; long long* ss2 = ss1 + M;
        if (IN(p0 + 0)) {
            pg8::Gemm g{F_H, (const bf16*)(wt + WT_IN), M, INC, DM}; pg8::StaticOrder S; S.init(M, INC, F.G, (int)blockIdx.x);
            pg8::EpiProj E{F_P16, F_LB + l * HGW, ss1, (const float*)(ws + WS_CF) + (size_t)l * BATCH * INC, INC, SEQ};
            pg8::gemm_phase<pg8::EpiProj, pg8::StaticOrder, true, true>(F.lds + RING_OFF, g, S, E);
            if (BOTH(p0 + 0)) GRID_BAR(p0 + 0);
        }
        if (IN(p0 + 1)) {
            PHASE_FRAME(Fl);
            hgrn2_a1_all(Fl);
            attn_all(Fl, args, l);
            if (BOTH(p0 + 1)) GRID_BAR(p0 + 1);
        }
        if (IN(p0 + 2)) { PHASE_FRAME(Fl); hgrn2_a2(Fl); if (BOTH(p0 + 2)) GRID_BAR(p0 + 2); }
        if (IN(p0 + 3)) {
            PHASE_FRAME(Fl);
            hgrn2_a3_all(Fl, args, l);
            if (BOTH(p0 + 3)) GRID_BAR(p0 + 3);
        }
        if (IN(p0 + 4)) {
            pg8::Gemm g{F_MIX, (const bf16*)(wt + WT_OUT), M, DM, DM}; pg8::StaticOrder S; S.init(M, DM, F.G, (int)blockIdx.x);
            pg8::EpiResid<true, false> E{xin, nullptr, xa, modl + 2 * DM, NMODC, SEQ, F_H, F_norm2_g + l * DM, modl + 4 * DM, ss2};
            pg8::gemm_phase<pg8::EpiResid<true, false>, pg8::StaticOrder, false, true>(F.lds + RING_OFF, g, S, E);
            if (BOTH(p0 + 4)) GRID_BAR(p0 + 4);
        }
        if (IN(p0 + 5)) {
            pg8::Gemm g{F_H, (const bf16*)(wt + WT_FI), M, 2 * DFF, DM}; pg8::StaticOrder S; S.init(M, 2 * DFF, F.G, (int)blockIdx.x);
            pg8::EpiSwiGLU E{F_HID, DFF, ss2, (const float*)(ws + WS_CF) + (size_t)DEPTH * BATCH * INC + (size_t)l * BATCH * 2 * DFF, 2 * DFF, SEQ};
            pg8::gemm_phase<pg8::EpiSwiGLU, pg8::StaticOrder, true, true>(F.lds + RING_OFF, g, S, E);
            if (BOTH(p0 + 5)) GRID_BAR(p0 + 5);
        }
        if (IN(p0 + 6)) {
            pg8::Gemm g{F_HID, (const bf16*)(wt + WT_FO), M, DM, DFF}; pg8::StaticOrder S; S.init(M, DM, F.G, (int)blockIdx.x);
            const bool nxt = (l + 1 < DEPTH);
            pg8::EpiResid<false, true> E{xin, F.out, xa, modl + 5 * DM, NMODC, SEQ, nxt ? F_H : nullptr, F_norm1_g + (nxt ? l + 1 : l) * DM, F_MOD + (size_t)(nxt ? l + 1 : l) * 2 * NMODC + DM, nxt ? ss2 + M : ss2};
            pg8::gemm_phase<pg8::EpiResid<false, true>, pg8::StaticOrder, false, true>(F.lds + RING_OFF, g, S, E);
            if (BOTH(p0 + 6)) GRID_BAR(p0 + 6);
        }
    }
#undef IN
#undef BOTH
}

extern "C" void kernel_launch(void* const* d_in, const int* in_sizes, int n_in, void* d_out, int out_size, void* d_ws, size_t ws_size, hipStream_t stream) {
    static int grid = 0;
    if (grid == 0) {
        if (n_in != 15 || in_sizes[0] != M * DM || out_size != M * DM || ws_size < WS_END) { fprintf(stderr, "kernel_launch: unexpected shapes (n_in %d, in0 %d, out %d, ws %zu < %zu); nothing launched\n", n_in, n_in > 0 ? in_sizes[0] : -1, out_size, ws_size, (size_t)WS_END); grid = -1; return; }
        int dev = 0, cus = 0, per_cu = 0;
        if (hipGetDevice(&dev) != hipSuccess || hipDeviceGetAttribute(&cus, hipDeviceAttributeMultiprocessorCount, dev) != hipSuccess) { grid = -1; return; }
        if (hipFuncSetAttribute((const void*)skel_fwd, hipFuncAttributeMaxDynamicSharedMemorySize, LDS_BYTES) != hipSuccess) { fprintf(stderr, "kernel_launch: hipFuncSetAttribute failed\n"); grid = -1; return; }
        if (hipOccupancyMaxActiveBlocksPerMultiprocessor(&per_cu, (const void*)skel_fwd, NWAVES * 64, LDS_BYTES) != hipSuccess || per_cu < 1)
            fprintf(stderr, "kernel_launch: note: occupancy query reports %d workgroups per CU\n", per_cu);
        (void)hipGetLastError();
        grid = cus;
        if (grid > 256) grid = 256;
    }
    if (grid < 0) return;
    if (hipMemsetAsync((char*)d_ws + WS_CTL, 0, CTL_ZERO_BYTES, stream) != hipSuccess) return;
    Args a{};
    for (int i = 0; i < 15; ++i) a.in[i] = (const float*)d_in[i];
    a.out = (float*)d_out; a.ws = (unsigned char*)d_ws; a.li = 0; a.pad = 0;
#if MK_PER_PHASE
    for (int p = 0; p < NPH; ++p) { a.ph_lo = p; a.ph_hi = p + 1; hipLaunchKernelGGL(skel_fwd, dim3(grid), dim3(NWAVES * 64), LDS_BYTES, stream, a); }
#else
    a.ph_lo = 0; a.ph_hi = NPH;
    hipLaunchKernelGGL(skel_fwd, dim3(grid), dim3(NWAVES * 64), LDS_BYTES, stream, a);
#endif
}
```

```cpp
#include <hip/hip_runtime.h>
#include <cstdio>
#include <cstdint>
namespace pg8 {
#define PG8_LAS __attribute__((address_space(3)))
typedef unsigned short bf16_t;
typedef short bf16x8 __attribute__((ext_vector_type(8)));
typedef float f32x4 __attribute__((ext_vector_type(4)));
typedef unsigned u32x4 __attribute__((ext_vector_type(4)));
constexpr int BM = 256, BK = 64, HALF = 128, HTB = HALF * BK * 2  , STAGE_BYTES = 8 * HTB, NXCD = 8, WGM = 8;

__host__ __device__ __forceinline__ int lds_byte(int r, int c) { const int st = (r >> 4) * 2 + (c >> 5), rr = r & 15, cc = c & 31, ob = rr * 64 + cc * 2; return st * 1024 + (ob ^ (((ob >> 9) & 1) << 5)); }
__host__ __device__ __forceinline__ void stage_rc(int b, int& R, int& C) { const int st = b / 1024, sb = b % 1024, swz = sb ^ (((sb >> 9) & 1) << 5); R = (st >> 1) * 16 + swz / 64; C = (st & 1) * 32 + (swz % 64) / 2; }
__host__ __device__ __forceinline__ int perm32(int rho) { const int n = rho >> 4, i = rho & 15; return 8 * (i >> 2) + 4 * n + (i & 3); }

struct Unit { int pm, pn; };
struct Gemm { const bf16_t* A; const bf16_t* Bt; int M, N, K; };

struct StaticOrder {
    int nM, nN, nwg, G, c;
    __host__ __device__ void init(int M, int N, int G_, int c_) { nM = M / BM; nN = N / BM; nwg = nM * nN; G = G_; c = c_; }
    __host__ __device__ bool next(int i, Unit& u) const {
        const long L = (long)i * G + c; if (L >= nwg) return false;
        int wgid = (int)L; { const int q = nwg / NXCD, r = nwg % NXCD, xcd = wgid % NXCD, off = wgid / NXCD; wgid = (xcd < r ? xcd * (q + 1) : r * (q + 1) + (xcd - r) * q) + off; }
        const int nig = WGM * nN, gid = wgid / nig, fm = gid * WGM, gsz = (nM - fm) < WGM ? (nM - fm) : WGM;
        u.pm = fm + ((wgid % nig) % gsz); u.pn = (wgid % nig) / gsz; return true;
    }
    __device__ __forceinline__ void a_ready(const Unit&) const {}
    __device__ __forceinline__ void done(const Unit&) const {}
};

__device__ __forceinline__ unsigned cvt_pk_bf16(float lo, float hi) { unsigned r; asm volatile("v_cvt_pk_bf16_f32 %0, %1, %2" : "=v"(r) : "v"(lo), "v"(hi)); return r; }
__device__ __forceinline__ unsigned cvt_pk_f16(float lo, float hi) { typedef _Float16 h2 __attribute__((ext_vector_type(2))); h2 v; v.x = (_Float16)lo; v.y = (_Float16)hi; return __builtin_bit_cast(unsigned, v); }
__device__ __forceinline__ float fsilu(float x) { return x * __builtin_amdgcn_rcpf(1.0f + __expf(-x)); }
__device__ __forceinline__ f32x4 fsilu4(f32x4 x) {
    f32x4 e = x * -1.4426950408889634f;
#pragma unroll
    for (int j = 0; j < 4; ++j) e[j] = __builtin_amdgcn_exp2f(e[j]);
    f32x4 d = e + 1.0f;
#pragma unroll
    for (int j = 0; j < 4; ++j) d[j] = __builtin_amdgcn_rcpf(d[j]);
    return x * d;
}

constexpr int P16_LD = 8192;
constexpr float RMS_EPS = 1e-6f;
__device__ __forceinline__ void fx_add(long long* p, float v, float scale) { atomicAdd((unsigned long long*)p, (unsigned long long)__float2ll_rn(v * scale)); }
__device__ __forceinline__ float fx_get(const long long* p, float inv_scale) { return (float)(*p) * inv_scale; }
constexpr float SS_SCALE = 65536.0f, SS_INV = 1.0f / 65536.0f, C_SCALE = 4294967296.0f, C_INV = 1.0f / 4294967296.0f;
struct EpiProj {
    static constexpr bool PERM = true, AFTER_DRAIN = false;
    bf16_t* P; const float* lb;
    const long long* ss; const float* cvec; int cstride, rows_per_batch;
    __device__ __forceinline__ void operator()(const f32x4 (&acc)[2][2][4][2], const Unit& u, int wr, int wc, int fr, int fq) const {
        const int sec = u.pn >> 2;
        const int row0 = u.pm * BM + wr * 64 + fr, col0 = u.pn * BM + wc * 32 + 8 * fq;
        const float* cb = cvec + (size_t)((u.pm * BM) / rows_per_batch) * cstride + col0;
        const float* lbp = lb + ((sec == 1) ? (col0 - 1024) : 0);
        long long sv[2][4]; f32x4 cc[2][2], ll[2][2];
#pragma unroll
        for (int ai = 0; ai < 2; ++ai)
#pragma unroll
            for (int m = 0; m < 4; ++m) sv[ai][m] = ss[row0 + ai * HALF + m * 16];
#pragma unroll
        for (int bj = 0; bj < 2; ++bj) { cc[bj][0] = *(const f32x4*)(cb + bj * HALF); cc[bj][1] = *(const f32x4*)(cb + bj * HALF + 4);
            ll[bj][0] = *(const f32x4*)(lbp + bj * HALF); ll[bj][1] = *(const f32x4*)(lbp + bj * HALF + 4); }
        asm volatile("" : "+v"(sv[0][0]), "+v"(sv[0][1]), "+v"(sv[0][2]), "+v"(sv[0][3]), "+v"(sv[1][0]), "+v"(sv[1][1]), "+v"(sv[1][2]), "+v"(sv[1][3]),
                          "+v"(cc[0][0]), "+v"(cc[0][1]), "+v"(cc[1][0]), "+v"(cc[1][1]), "+v"(ll[0][0]), "+v"(ll[0][1]), "+v"(ll[1][0]), "+v"(ll[1][1]));
        float rstd[2][4];
#pragma unroll
        for (int ai = 0; ai < 2; ++ai)
#pragma unroll
            for (int m = 0; m < 4; ++m) rstd[ai][m] = __builtin_amdgcn_rsqf((float)sv[ai][m] * (SS_INV * (1.0f / 2048.0f)) + RMS_EPS);
#pragma unroll
        for (int bj = 0; bj < 2; ++bj) {
            const f32x4 c0 = cc[bj][0], c1 = cc[bj][1];
            if (sec == 1) {
                const f32x4 l0 = ll[bj][0], l1 = ll[bj][1];
#pragma unroll
                for (int ai = 0; ai < 2; ++ai)
#pragma unroll
                    for (int m = 0; m < 4; ++m) { bf16_t* rowp = P + (size_t)(row0 + ai * HALF + m * 16) * P16_LD + col0 + bj * HALF; float lf[8];
#pragma unroll
                        for (int j = 0; j < 4; ++j) { const float fl0 = acc[ai][bj][m][0][j] * rstd[ai][m] + c0[j], fl1 = acc[ai][bj][m][1][j] * rstd[ai][m] + c1[j];
                            const float r0 = __builtin_amdgcn_rcpf(1.0f + __expf(-fl0)), r1 = __builtin_amdgcn_rcpf(1.0f + __expf(-fl1));
                            lf[j] = 0.6931471805599453f * __builtin_amdgcn_logf(fmaxf(l0[j] + (1.0f - l0[j]) * r0, 1e-30f)); lf[4 + j] = 0.6931471805599453f * __builtin_amdgcn_logf(fmaxf(l1[j] + (1.0f - l1[j]) * r1, 1e-30f)); }
                        u32x4 w; w.x = cvt_pk_f16(lf[0], lf[1]); w.y = cvt_pk_f16(lf[2], lf[3]); w.z = cvt_pk_f16(lf[4], lf[5]); w.w = cvt_pk_f16(lf[6], lf[7]);
                        *(u32x4*)(rowp) = w; }
            } else {
                const bool act = (sec == 0) || (sec == 3);
#pragma unroll
                for (int ai = 0; ai < 2; ++ai)
#pragma unroll
                    for (int m = 0; m < 4; ++m) { bf16_t* rowp = P + (size_t)(row0 + ai * HALF + m * 16) * P16_LD + col0 + bj * HALF;
                        f32x4 v0 = acc[ai][bj][m][0] * rstd[ai][m] + c0, v1 = acc[ai][bj][m][1] * rstd[ai][m] + c1;
                        if (act) { v0 = fsilu4(v0); v1 = fsilu4(v1); }
                        u32x4 w; w.x = cvt_pk_bf16(v0[0], v0[1]); w.y = cvt_pk_bf16(v0[2], v0[3]); w.z = cvt_pk_bf16(v1[0], v1[1]); w.w = cvt_pk_bf16(v1[2], v1[3]);
                        *(u32x4*)(rowp) = w; }
            }
        }
    }
};
template <bool OUT_DELTA, bool HAS_DIN> struct EpiResid {
    static constexpr bool PERM = true, AFTER_DRAIN = false;
    const float* base; float* out; bf16_t* dbuf; const float* gate; int gate_bstride, rows_per_batch;
    bf16_t* Hn; const float* gnext; const float* scnext; long long* ssn;
    __device__ __forceinline__ void operator()(const f32x4 (&acc)[2][2][4][2], const Unit& u, int wr, int wc, int fr, int fq) const {
        const int row0 = u.pm * BM + wr * 64 + fr, col0 = u.pn * BM + wc * 32 + 8 * fq, b = (u.pm * BM) / rows_per_batch;
        const float* g = gate + (size_t)b * gate_bstride + col0;
        float ssq[2][4];
#pragma unroll
        for (int ai = 0; ai < 2; ++ai)
#pragma unroll
            for (int m = 0; m < 4; ++m) ssq[ai][m] = 0.f;
        f32x4 gv[2][2], Gv[2][2];
#pragma unroll
        for (int bj = 0; bj < 2; ++bj) { gv[bj][0] = *(const f32x4*)(g + bj * HALF); gv[bj][1] = *(const f32x4*)(g + bj * HALF + 4); Gv[bj][0] = (f32x4){0.f, 0.f, 0.f, 0.f}; Gv[bj][1] = (f32x4){0.f, 0.f, 0.f, 0.f};
            if (Hn) { const float* sc = scnext + (size_t)b * gate_bstride + col0 + bj * HALF;
                Gv[bj][0] = *(const f32x4*)(gnext + col0 + bj * HALF) * (1.0f + *(const f32x4*)(sc)); Gv[bj][1] = *(const f32x4*)(gnext + col0 + bj * HALF + 4) * (1.0f + *(const f32x4*)(sc + 4)); } }
#pragma unroll
        for (int bj = 0; bj < 2; ++bj) {
            const f32x4 g0 = gv[bj][0], g1 = gv[bj][1], G0 = Gv[bj][0], G1 = Gv[bj][1];
#pragma unroll
            for (int ai = 0; ai < 2; ++ai)
#pragma unroll
                for (int m = 0; m < 4; ++m) { const size_t off = (size_t)(row0 + ai * HALF + m * 16) * 2048 + col0 + bj * HALF;
                    f32x4 x0 = __builtin_nontemporal_load((const f32x4*)(base + off)), x1 = __builtin_nontemporal_load((const f32x4*)(base + off + 4));
                    if constexpr (HAS_DIN) { const u32x4 dw = __builtin_nontemporal_load((const u32x4*)(dbuf + off));
                        x0 += (f32x4){__builtin_bit_cast(float, dw.x << 16), __builtin_bit_cast(float, dw.x & 0xffff0000u), __builtin_bit_cast(float, dw.y << 16), __builtin_bit_cast(float, dw.y & 0xffff0000u)};
                        x1 += (f32x4){__builtin_bit_cast(float, dw.z << 16), __builtin_bit_cast(float, dw.z & 0xffff0000u), __builtin_bit_cast(float, dw.w << 16), __builtin_bit_cast(float, dw.w & 0xffff0000u)}; }
                    f32x4 o0, o1;
                    if constexpr (OUT_DELTA) { const f32x4 d0 = g0 * acc[ai][bj][m][0], d1 = g1 * acc[ai][bj][m][1];
                        u32x4 w; w.x = cvt_pk_bf16(d0[0], d0[1]); w.y = cvt_pk_bf16(d0[2], d0[3]); w.z = cvt_pk_bf16(d1[0], d1[1]); w.w = cvt_pk_bf16(d1[2], d1[3]);
                        *(u32x4*)(dbuf + off) = w;
                        o0 = x0 + (f32x4){__builtin_bit_cast(float, w.x << 16), __builtin_bit_cast(float, w.x & 0xffff0000u), __builtin_bit_cast(float, w.y << 16), __builtin_bit_cast(float, w.y & 0xffff0000u)};
                        o1 = x1 + (f32x4){__builtin_bit_cast(float, w.z << 16), __builtin_bit_cast(float, w.z & 0xffff0000u), __builtin_bit_cast(float, w.w << 16), __builtin_bit_cast(float, w.w & 0xffff0000u)}; }
                    else { o0 = x0 + g0 * acc[ai][bj][m][0]; o1 = x1 + g1 * acc[ai][bj][m][1]; *(f32x4*)(out + off) = o0; *(f32x4*)(out + off + 4) = o1; }
                    if (Hn) { const f32x4 h0 = o0 * G0, h1 = o1 * G1;
                        u32x4 w; w.x = cvt_pk_bf16(h0[0], h0[1]); w.y = cvt_pk_bf16(h0[2], h0[3]); w.z = cvt_pk_bf16(h1[0], h1[1]); w.w = cvt_pk_bf16(h1[2], h1[3]);
                        *(u32x4*)(Hn + off) = w;
                        ssq[ai][m] += ((o0[0] * o0[0] + o0[1] * o0[1]) + (o0[2] * o0[2] + o0[3] * o0[3])) + ((o1[0] * o1[0] + o1[1] * o1[1]) + (o1[2] * o1[2] + o1[3] * o1[3])); } }
            if (bj == 0) asm volatile("" ::: "memory");
        }
        if (Hn) {
#pragma unroll
            for (int ai = 0; ai < 2; ++ai)
#pragma unroll
                for (int m = 0; m < 4; ++m) { float s = ssq[ai][m]; s += __shfl_xor(s, 16); s += __shfl_xor(s, 32);
                    if (fq == 0) fx_add(ssn + row0 + ai * HALF + m * 16, s, SS_SCALE); } }
    }
};
struct EpiSwiGLU {
    static constexpr bool PERM = true, AFTER_DRAIN = false;
    bf16_t* Hd; int ldh;
    const long long* ss; const float* cvec; int cstride, rows_per_batch;
    __device__ __forceinline__ void operator()(const f32x4 (&acc)[2][2][4][2], const Unit& u, int wr, int wc, int fr, int fq) const {
        const int row0 = u.pm * BM + wr * 64 + fr, col0 = u.pn * HALF + wc * 32 + 8 * fq;
        const float* cb = cvec + (size_t)((u.pm * BM) / rows_per_batch) * cstride + u.pn * BM + wc * 32 + 8 * fq;
        long long sv[2][4];
#pragma unroll
        for (int ai = 0; ai < 2; ++ai)
#pragma unroll
            for (int m = 0; m < 4; ++m) sv[ai][m] = ss[row0 + ai * HALF + m * 16];
        f32x4 cg0 = *(const f32x4*)(cb), cg1 = *(const f32x4*)(cb + 4), cu0 = *(const f32x4*)(cb + HALF), cu1 = *(const f32x4*)(cb + HALF + 4);
        asm volatile("" : "+v"(sv[0][0]), "+v"(sv[0][1]), "+v"(sv[0][2]), "+v"(sv[0][3]), "+v"(sv[1][0]), "+v"(sv[1][1]), "+v"(sv[1][2]), "+v"(sv[1][3]), "+v"(cg0), "+v"(cg1), "+v"(cu0), "+v"(cu1));
#pragma unroll
        for (int ai = 0; ai < 2; ++ai)
#pragma unroll
            for (int m = 0; m < 4; ++m) { bf16_t* rowp = Hd + (size_t)(row0 + ai * HALF + m * 16) * ldh + col0;
                const float rstd = __builtin_amdgcn_rsqf((float)sv[ai][m] * (SS_INV * (1.0f / 2048.0f)) + RMS_EPS);
                const f32x4 ga = acc[ai][0][m][0] * rstd + cg0, gb = acc[ai][0][m][1] * rstd + cg1, ua = acc[ai][1][m][0] * rstd + cu0, ub = acc[ai][1][m][1] * rstd + cu1;
                const f32x4 v0 = fsilu4(ga) * ua, v1 = fsilu4(gb) * ub;
                u32x4 w; w.x = cvt_pk_bf16(v0[0], v0[1]); w.y = cvt_pk_bf16(v0[2], v0[3]); w.z = cvt_pk_bf16(v1[0], v1[1]); w.w = cvt_pk_bf16(v1[2], v1[3]);
                *(u32x4*)rowp = w; }
    }
};

template <class Epi, class Sched, bool ALIGN_EPI = false, bool SP2 = false>
__device__ __forceinline__ void gemm_phase(PG8_LAS unsigned char* lds, const Gemm g, const Sched& S, const Epi& E) {
    int tid_ = threadIdx.x; asm volatile("" : "+v"(tid_));
    const int tid = tid_, wid = __builtin_amdgcn_readfirstlane(tid >> 6), lane = tid & 63, wr = wid >> 2, wc = wid & 3, fr = lane & 15, fq = lane >> 4;
    const int K = g.K, nt = K / BK;
    unsigned voffA[2], voffB[2];
#pragma unroll
    for (int i = 0; i < 2; ++i) { int R, C; stage_rc(tid * 16 + i * 8192, R, C); const int Rb = Epi::PERM ? ((R & ~31) + perm32(R & 31)) : R;
        voffA[i] = (unsigned)(R * K + C) * 2u; voffB[i] = (unsigned)(Rb * K + C) * 2u; }
    const size_t kstep = (size_t)(BK * 2);
    const size_t hstep = (size_t)HALF * K * 2;
    const size_t tstep = 2 * hstep;
    const unsigned ldsw = (unsigned)wid * 1024u;
    const int aoff = lds_byte(wr * 64 + fr, fq * 8), boff = lds_byte(wc * 32 + fr, fq * 8);
#define PG8_SA(b, h) (((b) * 2 + (h)) * HTB)
#define PG8_SB(b, h) ((4 + (b) * 2 + (h)) * HTB)
#define PG8_STAGE(bufoff, gbase, voff) do { const char* gb_ = (const char*)(gbase); asm volatile("" : "+s"(gb_)); _Pragma("unroll") for (int _i = 0; _i < 2; ++_i) { unsigned vo_ = (voff)[_i]; asm volatile("" : "+v"(vo_));        \
        __builtin_amdgcn_global_load_lds((const unsigned*)(gb_ + vo_), (PG8_LAS unsigned*)(lds + (bufoff) + ldsw + _i * 8192), 16, 0, 0); } } while (0)
#define PG8_LDA(dst, b, h) do { _Pragma("unroll") for (int m = 0; m < 4; ++m) _Pragma("unroll") for (int k = 0; k < 2; ++k) dst[m][k] = *(const PG8_LAS bf16x8*)(lds + PG8_SA(b, h) + aoff + m * 2048 + k * 1024); } while (0)
#define PG8_LDB(dst, b, h) do { _Pragma("unroll") for (int n = 0; n < 2; ++n) _Pragma("unroll") for (int k = 0; k < 2; ++k) dst[n][k] = *(const PG8_LAS bf16x8*)(lds + PG8_SB(b, h) + boff + n * 2048 + k * 1024); } while (0)
#define PG8_MMA(ai, bj, At, Bt) do { __builtin_amdgcn_s_setprio(1); _Pragma("unroll") for (int m = 0; m < 4; ++m) _Pragma("unroll") for (int n = 0; n < 2; ++n) _Pragma("unroll") for (int k = 0; k < 2; ++k) \
        acc[ai][bj][m][n] = __builtin_amdgcn_mfma_f32_16x16x32_bf16(Bt[n][k], At[m][k], acc[ai][bj][m][n], 0, 0, 0); __builtin_amdgcn_s_setprio(0); } while (0)
#define PG8_WAIT_V(n) asm volatile("s_waitcnt vmcnt(" #n ")" ::: "memory")
#define PG8_WAIT_L(n) asm volatile("s_waitcnt lgkmcnt(" #n ")" ::: "memory")
#define PG8_BAR __builtin_amdgcn_s_barrier()
#define PG8_SCHED __builtin_amdgcn_sched_barrier(0)
    Unit cur, nxt; int ui = 0;
    if (!S.next(0, cur)) return;
    f32x4 acc[2][2][4][2];
#pragma unroll
    for (int a = 0; a < 2; ++a)
#pragma unroll
        for (int b = 0; b < 2; ++b)
#pragma unroll
            for (int m = 0; m < 4; ++m)
#pragma unroll
                for (int n = 0; n < 2; ++n) acc[a][b][m][n] = (f32x4){0.f, 0.f, 0.f, 0.f};
    bf16x8 At[4][2], B0[2][2], B1[2][2];
    const char* cA = (const char*)g.A + (size_t)cur.pm * tstep; const char* cB = (const char*)g.Bt + (size_t)cur.pn * tstep;
    S.a_ready(cur);
    if constexpr (SP2) {
        PG8_STAGE(PG8_SB(0, 0), cB, voffB); PG8_STAGE(PG8_SB(0, 1), cB + hstep, voffB); PG8_STAGE(PG8_SA(0, 0), cA, voffA); PG8_STAGE(PG8_SA(0, 1), cA + hstep, voffA);
        if (wr == 1) PG8_BAR;
        PG8_WAIT_V(2); PG8_BAR;
        PG8_STAGE(PG8_SB(1, 0), cB + kstep, voffB); PG8_STAGE(PG8_SA(1, 0), cA + kstep, voffA); PG8_STAGE(PG8_SB(1, 1), cB + hstep + kstep, voffB);
        PG8_WAIT_V(6); PG8_BAR;
    } else {
        PG8_STAGE(PG8_SB(0, 0), cB, voffB); PG8_STAGE(PG8_SA(0, 0), cA, voffA); PG8_STAGE(PG8_SB(0, 1), cB + hstep, voffB); PG8_STAGE(PG8_SA(0, 1), cA + hstep, voffA);
        if (wr == 1) PG8_BAR;
        PG8_WAIT_V(4); PG8_BAR;
        PG8_STAGE(PG8_SB(1, 0), cB + kstep, voffB); PG8_STAGE(PG8_SA(1, 0), cA + kstep, voffA); PG8_STAGE(PG8_SB(1, 1), cB + hstep + kstep, voffB);
        PG8_WAIT_V(6); PG8_BAR;
    }
    for (;;) {
        const bool has_next = S.next(ui + 1, nxt);
        const char* nA = has_next ? (const char*)g.A + (size_t)nxt.pm * tstep : cA; const char* nB = has_next ? (const char*)g.Bt + (size_t)nxt.pn * tstep : cB;
        for (int t = 0; t < nt; t += 2) {
            const bool last = (t == nt - 2);
            const char* a1 = cA + (size_t)(t + 1) * kstep;
            const char* a2 = last ? nA : cA + (size_t)(t + 2) * kstep; const char* b2 = last ? nB : cB + (size_t)(t + 2) * kstep;
            const char* a3 = a2 + kstep; const char* b3 = b2 + kstep;
            if (last && has_next) S.a_ready(nxt);
            if constexpr (SP2) {
            PG8_LDB(B0, 0, 0); PG8_LDB(B1, 0, 1); PG8_SCHED; PG8_LDA(At, 0, 0); PG8_STAGE(PG8_SA(1, 1), a1 + hstep, voffA);
            PG8_WAIT_V(8); PG8_WAIT_L(0); PG8_BAR; PG8_MMA(0, 0, At, B0); PG8_MMA(0, 1, At, B1); PG8_BAR; PG8_SCHED;
            PG8_LDA(At, 0, 1); PG8_STAGE(PG8_SB(0, 0), b2, voffB); PG8_STAGE(PG8_SB(0, 1), b2 + hstep, voffB); PG8_STAGE(PG8_SA(0, 0), a2, voffA);
            PG8_WAIT_V(8); PG8_WAIT_L(0); PG8_BAR; PG8_MMA(1, 0, At, B0); PG8_MMA(1, 1, At, B1); PG8_BAR; PG8_SCHED;
            PG8_LDB(B0, 1, 0); PG8_LDB(B1, 1, 1); PG8_SCHED; PG8_LDA(At, 1, 0); PG8_STAGE(PG8_SA(0, 1), a2 + hstep, voffA);
            PG8_WAIT_V(8); PG8_WAIT_L(0); PG8_BAR; PG8_MMA(0, 0, At, B0); PG8_MMA(0, 1, At, B1); PG8_BAR; PG8_SCHED;
            PG8_LDA(At, 1, 1); PG8_STAGE(PG8_SB(1, 0), b3, voffB); PG8_STAGE(PG8_SB(1, 1), b3 + hstep, voffB); PG8_STAGE(PG8_SA(1, 0), a3, voffA);
            PG8_WAIT_V(8); PG8_WAIT_L(0); PG8_BAR; PG8_MMA(1, 0, At, B0); PG8_MMA(1, 1, At, B1); PG8_BAR; PG8_SCHED;
            } else {
            PG8_LDB(B0, 0, 0); PG8_SCHED; PG8_LDA(At, 0, 0); PG8_STAGE(PG8_SA(1, 1), a1 + hstep, voffA);
            PG8_WAIT_L(8); PG8_BAR; PG8_WAIT_L(0); PG8_MMA(0, 0, At, B0); PG8_BAR; PG8_SCHED;
            PG8_LDB(B1, 0, 1); PG8_STAGE(PG8_SB(0, 0), b2, voffB);
            PG8_BAR; PG8_WAIT_L(0); PG8_MMA(0, 1, At, B1); PG8_BAR;
            PG8_LDA(At, 0, 1); PG8_STAGE(PG8_SA(0, 0), a2, voffA);
            PG8_BAR; PG8_WAIT_L(0); PG8_MMA(1, 0, At, B0); PG8_BAR; PG8_SCHED;
            PG8_STAGE(PG8_SB(0, 1), b2 + hstep, voffB);
            PG8_WAIT_V(6); PG8_BAR; PG8_MMA(1, 1, At, B1); PG8_BAR;
            PG8_LDB(B0, 1, 0); PG8_SCHED; PG8_LDA(At, 1, 0); PG8_STAGE(PG8_SA(0, 1), a2 + hstep, voffA);
            PG8_WAIT_L(8); PG8_BAR; PG8_WAIT_L(0); PG8_MMA(0, 0, At, B0); PG8_BAR; PG8_SCHED;
            PG8_LDB(B1, 1, 1); PG8_STAGE(PG8_SB(1, 0), b3, voffB);
            PG8_BAR; PG8_WAIT_L(0); PG8_MMA(0, 1, At, B1); PG8_BAR;
            PG8_LDA(At, 1, 1); PG8_STAGE(PG8_SA(1, 0), a3, voffA);
            PG8_BAR; PG8_WAIT_L(0); PG8_MMA(1, 0, At, B0); PG8_BAR; PG8_SCHED;
            PG8_STAGE(PG8_SB(1, 1), b3 + hstep, voffB);
            PG8_WAIT_V(6); PG8_BAR; PG8_MMA(1, 1, At, B1); PG8_BAR;
            }
        }
        if constexpr (ALIGN_EPI) { if (wr == 0) PG8_BAR; }
        if constexpr (!Epi::AFTER_DRAIN) { E(acc, cur, wr, wc, fr, fq); S.done(cur); }
        if (!has_next) break;
#pragma unroll
        for (int a = 0; a < 2; ++a)
#pragma unroll
            for (int b = 0; b < 2; ++b)
#pragma unroll
                for (int m = 0; m < 4; ++m)
#pragma unroll
                    for (int n = 0; n < 2; ++n) acc[a][b][m][n] = (f32x4){0.f, 0.f, 0.f, 0.f};
        cur = nxt; cA = nA; cB = nB; ++ui;
        if constexpr (ALIGN_EPI) { if (wr == 1) PG8_BAR; }
    }
    PG8_WAIT_V(0);
    if constexpr (!ALIGN_EPI) { if (wr == 0) PG8_BAR; }
    PG8_BAR;
    if constexpr (Epi::AFTER_DRAIN) { E.fused(acc, cur, wr, wc, fr, fq, lds, wid, lane); S.done(cur); }
#undef PG8_SA
#undef PG8_SB
#undef PG8_STAGE
#undef PG8_LDA
#undef PG8_LDB
#undef PG8_MMA
#undef PG8_WAIT_V
#undef PG8_WAIT_L
#undef PG8_BAR
#undef PG8_SCHED
}
}

constexpr int NWAVES = 8;
#ifndef MK_PER_PHASE
#define MK_PER_PHASE 0
#endif
constexpr int BATCH = 2, SEQ = 8192, DM = 2048, DEPTH = 4, M = BATCH * SEQ, INC = 7168, DFF = 5632, NMODC = 6 * DM;
constexpr int HGW = 1024, HD = 128, NH = 8;
constexpr float EPS = 1e-6f;
constexpr int NPL = 7;
constexpr int NPH = 3 + DEPTH * NPL;

constexpr size_t MiB = 1u << 20;
constexpr size_t WS_CTL = 0, CTL_ZERO_BYTES = 3 * MiB;
constexpr size_t WS_SS = 256 * 1024;
constexpr size_t WS_C1 = 256 * 1024 + 1024 * 1024;
constexpr size_t WS_C2 = WS_C1 + (size_t)DEPTH * BATCH * INC * 8;
static_assert(WS_C2 + (size_t)DEPTH * BATCH * 2 * DFF * 8 <= CTL_ZERO_BYTES, "accumulators inside the memset region");
constexpr size_t WS_MOD = 3 * MiB;
constexpr size_t WS_CF = 4 * MiB;
constexpr size_t WS_LB = 3 * MiB + 512 * 1024;
constexpr size_t WS_WT = 5 * MiB, WT_LAYER = 102 * MiB;
constexpr size_t WT_IN = 0, WT_OUT = 28 * MiB, WT_FI = 36 * MiB, WT_FO = 80 * MiB;
constexpr size_t WS_H = WS_WT + DEPTH * WT_LAYER;
constexpr size_t WS_P16 = WS_H + 64 * MiB;
constexpr size_t WS_MIX = WS_P16 + 256 * MiB;
constexpr size_t WS_HID = WS_MIX + 64 * MiB;
constexpr size_t WS_SLOC = WS_HID + 176 * MiB;
constexpr size_t WS_DEC = WS_SLOC + 64 * MiB;
constexpr size_t WS_XA = WS_DEC + 1 * MiB;
constexpr size_t WS_SPREV = WS_XA + 64 * MiB;
constexpr size_t WS_END = WS_SPREV + 64 * MiB;
static_assert((size_t)INC * DM * 2 == 28 * MiB && (size_t)DM * DM * 2 == 8 * MiB && (size_t)2 * DFF * DM * 2 == 44 * MiB && (size_t)DM * DFF * 2 == 22 * MiB, "weight copy sizes");
static_assert((size_t)M * DFF * 2 == 176 * MiB && (size_t)M * 8192 * 2 == 256 * MiB, "activation sizes");
constexpr int CW_TMO = 0, CW_CODE = 1;
constexpr int CW_BAR = 4096;
constexpr int CW_A1 = 8192;

constexpr int RING_OFF = 0, RING_BYTES = 131072;
constexpr int LDSCTL_OFF = RING_BYTES, MISC_OFF = LDSCTL_OFF + 320;
constexpr int LDS_BYTES = 147456;
static_assert(MISC_OFF + 128 <= LDS_BYTES, "LDS map");

#define GAS __attribute__((address_space(1)))
#define LAS __attribute__((address_space(3)))
typedef unsigned short bf16;
typedef unsigned v4u __attribute__((ext_vector_type(4)));
typedef unsigned v2u __attribute__((ext_vector_type(2)));
typedef float f32x4 __attribute__((ext_vector_type(4)));
typedef float f32x2 __attribute__((ext_vector_type(2)));
typedef GAS unsigned gu32;
typedef GAS unsigned long long gu64;
#define RLX_AGENT __ATOMIC_RELAXED, __HIP_MEMORY_SCOPE_AGENT
#define LDS_WAIT() asm volatile("s_waitcnt lgkmcnt(0)" ::: "memory")
#define VM_WAIT() asm volatile("s_waitcnt vmcnt(0)" ::: "memory")
__device__ __forceinline__ unsigned f2bf(float f) { unsigned u = __builtin_bit_cast(unsigned, f); return (u + 0x7fffu + ((u >> 16) & 1u)) >> 16; }
typedef float f32x2_t_ __attribute__((ext_vector_type(2))); typedef __bf16 bf16x2_t_ __attribute__((ext_vector_type(2)));
__device__ __forceinline__ unsigned pk2(float lo, float hi) { const f32x2_t_ v = {lo, hi}; const bf16x2_t_ b = __builtin_convertvector(v, bf16x2_t_); return __builtin_bit_cast(unsigned, b); }
__device__ __forceinline__ float bflo(unsigned w) { return __builtin_bit_cast(float, w << 16); }
__device__ __forceinline__ float bfhi(unsigned w) { return __builtin_bit_cast(float, w & 0xffff0000u); }
__device__ __forceinline__ float h2f(unsigned short hbits) { return (float)__builtin_bit_cast(_Float16, hbits); }

#define XB_TMO      128
#define XB_XCNT(j)  (256  + 64 * (j))
#define XB_XSUB(j)  (1280 + 64 * (j))
#define XB_XGEN(j)  (2304 + 64 * (j))
#define XB_TOP      3328
#define XB_TOPGEN   3392
#define XCD_BAR_WORDS 3456
#define XB_SPIN_CAP (1u << 18)

__device__ __forceinline__ unsigned xb_ld(unsigned* p)              { return __hip_atomic_load(p, __ATOMIC_RELAXED, __HIP_MEMORY_SCOPE_AGENT); }
__device__ __forceinline__ unsigned xb_add(unsigned* p, unsigned v) { return __hip_atomic_fetch_add(p, v, __ATOMIC_RELAXED, __HIP_MEMORY_SCOPE_AGENT); }
__device__ __forceinline__ unsigned xb_xcc_id() { return (unsigned)__builtin_amdgcn_s_getreg((3 << 11) | 20) & 0xFu; }
#define XB_SPIN(cond, bar) do { unsigned _sp = 0; while (cond) { __builtin_amdgcn_s_sleep(1); \
    if ((++_sp & 255u) == 0u) { if (xb_ld(&(bar)[XB_TMO])) break; if (_sp > XB_SPIN_CAP) { atomicAdd(&(bar)[XB_TMO], 1u); break; } } } } while (0)

struct XcdBarrier {
    unsigned* bar; unsigned x;
    volatile LAS unsigned* st;
};

__device__ __forceinline__ XcdBarrier xcd_barrier_post(unsigned* bar, volatile LAS unsigned* st) {
    XcdBarrier b; b.bar = bar; b.x = xb_xcc_id(); b.st = st;
    if (threadIdx.x == 0) (void)xb_add(&bar[XB_XCNT(b.x)], 1u);
    return b;
}
__device__ __forceinline__ void xcd_barrier_complete(unsigned* bar, unsigned x, unsigned& nloc, unsigned& nx) {
    const unsigned G = gridDim.x * gridDim.y * gridDim.z;
    unsigned sum, cnt, mine, sp = 0u;
    for (;;) {
        sum = 0u; cnt = 0u; mine = 0u;
#pragma unroll
        for (unsigned j = 0; j < 16; ++j) { const unsigned c = xb_ld(&bar[XB_XCNT(j)]); sum += c; cnt += (c > 0u) ? 1u : 0u; mine = (j == x) ? c : mine; }
        if (sum == G) break;
        __builtin_amdgcn_s_sleep(1);
        if ((++sp & 255u) == 0u) { if (xb_ld(&bar[XB_TMO])) break; if (sp > XB_SPIN_CAP) { atomicAdd(&bar[XB_TMO], 1u); break; } }
    }
    nloc = mine > 0u ? mine : 1u; nx = cnt > 0u ? cnt : 1u;
}

__device__ __forceinline__ void xcd_barrier(const XcdBarrier& b) {
    asm volatile("s_waitcnt vmcnt(0)" ::: "memory");
    __syncthreads();
    if (threadIdx.x == 0) {
        unsigned* bar = b.bar;
        __builtin_amdgcn_s_waitcnt(0);
        unsigned nloc = b.st[0], nx = b.st[1];
        if (nloc == 0u) { xcd_barrier_complete(bar, b.x, nloc, nx); b.st[0] = nloc; b.st[1] = nx; }
        const unsigned old = xb_add(&bar[XB_XSUB(b.x)], 1u);
        const unsigned gen = old / nloc;
        if (old + 1u == (gen + 1u) * nloc) {
            __builtin_amdgcn_fence(__ATOMIC_RELEASE, "agent");
            asm volatile("s_waitcnt vmcnt(0)" ::: "memory");
            const unsigned og = xb_add(&bar[XB_TOP], 1u);
            const unsigned tg = og / nx;
            if (og + 1u == (tg + 1u) * nx) xb_add(&bar[XB_TOPGEN], 1u);
            else XB_SPIN(xb_ld(&bar[XB_TOPGEN]) == tg, bar);
            __builtin_amdgcn_fence(__ATOMIC_ACQUIRE, "agent");
            xb_add(&bar[XB_XGEN(b.x)], 1u);
            asm volatile("s_waitcnt vmcnt(0)" ::: "memory");
        } else {
            XB_SPIN(xb_ld(&bar[XB_XGEN(b.x)]) == gen, bar);
            __builtin_amdgcn_fence(__ATOMIC_ACQUIRE, "agent");
            asm volatile("s_waitcnt vmcnt(0)" ::: "memory");
        }
    }
    __syncthreads();
}

struct Args { const float* in[15]; float* out; unsigned char* ws; int ph_lo, ph_hi, li, pad; };
struct Frame {
    LAS unsigned char* lds;
    volatile LAS unsigned* MISC;
    gu32* ctl;
    int tid, lane, wave;
    int vcu, G;
    float* out;
    unsigned char* ws;
};
#define F_x (args.in[0])
#define F_c (args.in[1])
#define F_norm1_g (args.in[2])
#define F_w_in (args.in[3])
#define F_hg_lb_logits (args.in[4])
#define F_hg_out_g (args.in[5])
#define F_sb_q_g (args.in[6])
#define F_sb_k_g (args.in[7])
#define F_sb_out_g (args.in[8])
#define F_w_out (args.in[9])
#define F_norm2_g (args.in[10])
#define F_w_ffn_in (args.in[11])
#define F_w_ffn_out (args.in[12])
#define F_w_ada (args.in[13])
#define F_b_ada (args.in[14])
#define F_MOD ((float*)(F.ws + WS_MOD))
#define F_LB ((float*)(F.ws + WS_LB))
#define F_H ((bf16*)(F.ws + WS_H))
#define F_P16 ((bf16*)(F.ws + WS_P16))
#define F_MIX ((bf16*)(F.ws + WS_MIX))
#define F_HID ((bf16*)(F.ws + WS_HID))
template <int CTRL> __device__ __forceinline__ float dpp_f(float v) { return __builtin_bit_cast(float, __builtin_amdgcn_update_dpp(0, __builtin_bit_cast(int, v), CTRL, 0xf, 0xf, false)); }
__device__ __forceinline__ float quad_sum(float v) { v += dpp_f<0xB1>(v); v += dpp_f<0x4E>(v); return v; }
__device__ __forceinline__ float row16_sum(float v) { v = quad_sum(v); v += dpp_f<0x141>(v); v += dpp_f<0x140>(v); return v; }
__device__ __forceinline__ float wave_sum(float v) {
    v = row16_sum(v);
    const int vi = __builtin_bit_cast(int, v);
    const float r0 = __builtin_bit_cast(float, __builtin_amdgcn_readlane(vi, 0)), r1 = __builtin_bit_cast(float, __builtin_amdgcn_readlane(vi, 16)), r2 = __builtin_bit_cast(float, __builtin_amdgcn_readlane(vi, 32)), r3 = __builtin_bit_cast(float, __builtin_amdgcn_readlane(vi, 48));
    return (r0 + r1) + (r2 + r3);
}

#define PHASE_FRAME(Fl) Frame Fl = F; { int t_ = F.tid; asm volatile("" : "+v"(t_)); Fl.tid = t_; Fl.lane = t_ & 63; Fl.wave = __builtin_amdgcn_readfirstlane(t_ >> 6); int v_ = F.vcu; asm volatile("" : "+s"(v_)); Fl.vcu = v_; }
__device__ __forceinline__ void transpose_item(const float* W, int K, int N, bf16* WT, int k0, int n_src0, int n_dst0, LAS float* scr, int lane, const float* sh, int sh_bstride, long long* cdst, int cstride) {
    LAS float* shl = scr + 64 * 33;
    if (sh) { shl[lane] = sh[k0 + lane]; shl[64 + lane] = sh[sh_bstride + k0 + lane]; }
#pragma unroll 8
    for (int i = 0; i < 32; ++i) { const int kk = 2 * i + (lane >> 5); scr[kk * 33 + (lane & 31)] = W[(size_t)(k0 + kk) * N + n_src0 + (lane & 31)]; }
    LDS_WAIT(); asm volatile("" ::: "memory");
    const int c = lane & 7;
#pragma unroll
    for (int j = 0; j < 4; ++j) { const int n = (lane >> 3) + 8 * j; const LAS float* s = scr + (8 * c) * 33 + n;
        v4u o; o.x = pk2(s[0 * 33], s[1 * 33]); o.y = pk2(s[2 * 33], s[3 * 33]); o.z = pk2(s[4 * 33], s[5 * 33]); o.w = pk2(s[6 * 33], s[7 * 33]);
        *(GAS v4u*)(WT + (size_t)(n_dst0 + n) * K + k0 + 8 * c) = o; }
    if (sh) { const int n = lane & 31, hf = lane >> 5; float s0 = 0.f, s1 = 0.f;
#pragma unroll 8
        for (int i = 0; i < 32; ++i) { const int kk = 32 * hf + i; const float w = scr[kk * 33 + n]; s0 += shl[kk] * w; s1 += shl[64 + kk] * w; }
        s0 += __shfl_xor(s0, 32); s1 += __shfl_xor(s1, 32);
        if (hf == 0) { pg8::fx_add(cdst + n_dst0 + n, s0, pg8::C_SCALE); pg8::fx_add(cdst + cstride + n_dst0 + n, s1, pg8::C_SCALE); } }
    LDS_WAIT(); asm volatile("" ::: "memory");
}
__device__ __forceinline__ void mod_unit(Frame& F, const Args& args, int unit) {
    const int l = unit / 48, cb = unit % 48;
    LAS float* cond = (LAS float*)(F.lds);
    LAS float* part = (LAS float*)(F.lds + 16384);
    for (int i = F.tid; i < 2 * DM; i += NWAVES * 64) { const float v = F_c[i]; cond[i] = v / (1.0f + __expf(-v)); }
    __syncthreads();
    const float* W = F_w_ada + (size_t)l * DM * NMODC + cb * 256 + F.lane * 4;
    f32x4 a0 = {0.f, 0.f, 0.f, 0.f}, a1 = {0.f, 0.f, 0.f, 0.f};
    const int kb = F.wave * 256;
#pragma unroll 32
    for (int k = 0; k < 256; ++k) { const f32x4 w = *(const GAS f32x4*)(W + (size_t)(kb + k) * NMODC); a0 += cond[kb + k] * w; a1 += cond[DM + kb + k] * w; }
    *(LAS f32x4*)(part + (F.wave * 2 + 0) * 256 + F.lane * 4) = a0;
    *(LAS f32x4*)(part + (F.wave * 2 + 1) * 256 + F.lane * 4) = a1;
    __syncthreads();
    { const int b = F.tid >> 8, col = F.tid & 255; float s = F_b_ada[l * NMODC + cb * 256 + col];
#pragma unroll
      for (int w = 0; w < 8; ++w) s += part[(w * 2 + b) * 256 + col];
      F_MOD[(size_t)(l * 2 + b) * NMODC + cb * 256 + col] = s; }
    __syncthreads();
}
__device__ __forceinline__ void lb_table(Frame& F, const Args& args) {
    for (int d = F.tid; d < HGW; d += NWAVES * 64) {
        const float x0 = F_hg_lb_logits[d], x1 = F_hg_lb_logits[HGW + d], x2 = F_hg_lb_logits[2 * HGW + d], x3 = F_hg_lb_logits[3 * HGW + d];
        const float mx = fmaxf(fmaxf(x0, x1), fmaxf(x2, x3));
        const float e0 = expf(x0 - mx), e1 = expf(x1 - mx), e2 = expf(x2 - mx), e3 = expf(x3 - mx), inv = 1.0f / (e0 + e1 + e2 + e3);
        const float p1 = e1 * inv, p2 = e2 * inv, p3 = e3 * inv;
        F_LB[d] = 0.f; F_LB[HGW + d] = p1; F_LB[2 * HGW + d] = p1 + p2; F_LB[3 * HGW + d] = (p1 + p2) + p3;
    }
}
__device__ __forceinline__ void p0_prologue_a(Frame& F, const Args& args) {
    if (F.vcu < DEPTH * 16) { const int l = F.vcu >> 4, j = F.vcu & 15; mod_unit(F, args, l * 48 + ((j < 8) ? j : 24 + (j - 8))); }
    if (F.vcu == F.G - 1) lb_table(F, args);
    __syncthreads();
    LAS float* scr = (LAS float*)(F.lds + RING_OFF + F.wave * 16384);
    const int gw = F.vcu * NWAVES + F.wave, NGW = F.G * NWAVES;
    constexpr int I_OUT = (DM / 64) * (DM / 32), I_FO = (DFF / 64) * (DM / 32), I_LAYER = I_OUT + I_FO;
    for (int it = gw; it < DEPTH * I_LAYER; it += NGW) {
        const int l = it / I_LAYER; int r = it % I_LAYER;
        unsigned char* wt = F.ws + WS_WT + (size_t)l * WT_LAYER;
        if (r < I_OUT) { const int nblk = DM / 32, kb = r / nblk, nb = r % nblk;
            transpose_item(F_w_out + (size_t)l * DM * DM, DM, DM, (bf16*)(wt + WT_OUT), 64 * kb, 32 * nb, 32 * nb, scr, F.lane, nullptr, 0, nullptr, 0); continue; } r -= I_OUT;
        { const int nblk = DM / 32, kb = r / nblk, nb = r % nblk;
            transpose_item(F_w_ffn_out + (size_t)l * DFF * DM, DFF, DM, (bf16*)(wt + WT_FO), 64 * kb, 32 * nb, 32 * nb, scr, F.lane, nullptr, 0, nullptr, 0); }
    }
}
__device__ __forceinline__ void p0_prologue_b(Frame& F, const Args& args) {
    if (F.vcu < DEPTH * 32) { const int l = F.vcu >> 5, j = F.vcu & 31; mod_unit(F, args, l * 48 + ((j < 16) ? 8 + j : 32 + (j - 16))); }
    __syncthreads();
    LAS float* scr = (LAS float*)(F.lds + RING_OFF + F.wave * 16384);
    const int gw = F.vcu * NWAVES + F.wave, NGW = F.G * NWAVES;
    constexpr int I_IN = (DM / 64) * (INC / 32), I_FI = (DM / 64) * (2 * DFF / 32), I_LAYER = I_IN + I_FI;
    for (int it = gw; it < DEPTH * I_LAYER; it += NGW) {
        const int l = it / I_LAYER; int r = it % I_LAYER;
        unsigned char* wt = F.ws + WS_WT + (size_t)l * WT_LAYER;
        const float* modl = F_MOD + (size_t)l * 2 * NMODC;
        if (r < I_IN) { const int nblk = INC / 32, kb = r / nblk, nb = r % nblk;
            transpose_item(F_w_in + (size_t)l * DM * INC, DM, INC, (bf16*)(wt + WT_IN), 64 * kb, 32 * nb, 32 * nb, scr, F.lane, modl, NMODC, (long long*)(F.ws + WS_C1) + (size_t)l * BATCH * INC, INC); continue; } r -= I_IN;
        { const int nblk = 2 * DFF / 32, kb = r / nblk, nb = r % nblk, p = nb >> 3, q = nb & 7;
            const int nsrc = (q < 4) ? (128 * p + 32 * q) : (DFF + 128 * p + 32 * (q - 4));
            transpose_item(F_w_ffn_in + (size_t)l * DM * 2 * DFF, DM, 2 * DFF, (bf16*)(wt + WT_FI), 64 * kb, nsrc, 32 * nb, scr, F.lane, modl + 3 * DM, NMODC, (long long*)(F.ws + WS_C2) + (size_t)l * BATCH * 2 * DFF, 2 * DFF); }
    }
}
__device__ __forceinline__ void norm0_phase(Frame& F, const float* x, const float* g, const float* modl, int sc_off, long long* ss) {
    const int gw = F.vcu * NWAVES + F.wave, NGW = F.G * NWAVES;
    for (int row = gw; row < M; row += NGW) {
        const float* mb = modl + (size_t)(row / SEQ) * NMODC;
        const GAS f32x4* xr = (const GAS f32x4*)(x + (size_t)row * DM) + F.lane;
        f32x4 v[8]; float s = 0.f;
#pragma unroll
        for (int j = 0; j < 8; ++j) { v[j] = xr[64 * j]; s += (v[j].x * v[j].x + v[j].y * v[j].y) + (v[j].z * v[j].z + v[j].w * v[j].w); }
        s = wave_sum(s);
        if (F.lane == 0) ss[row] = __float2ll_rn(s * pg8::SS_SCALE);
        GAS v2u* o8 = (GAS v2u*)(F_H + (size_t)row * DM) + F.lane;
#pragma unroll
        for (int j = 0; j < 8; ++j) { const int col = 4 * F.lane + 256 * j;
            const f32x4 gg = *(const GAS f32x4*)(g + col), sc = *(const GAS f32x4*)(mb + sc_off + col);
            const f32x4 y = v[j] * gg * (1.0f + sc);
            v2u w; w.x = pk2(y.x, y.y); w.y = pk2(y.z, y.w); o8[64 * j] = w; }
    }
}

typedef short bf16x8 __attribute__((ext_vector_type(8)));
constexpr int P16S = pg8::P16_LD;
constexpr int TS = 136;
constexpr int VS = 72;
constexpr int VR = 144;
constexpr int HG_UNITS = BATCH * NH * (SEQ / 64);
typedef short s16x4 __attribute__((ext_vector_type(4)));
__device__ __forceinline__ bf16x8 tr_frag(const LAS unsigned short* p0, const LAS unsigned short* p1) {
    const s16x4 a = __builtin_bit_cast(s16x4, __builtin_amdgcn_ds_read_tr16_b64_v4i16((LAS s16x4*)p0)), b = __builtin_bit_cast(s16x4, __builtin_amdgcn_ds_read_tr16_b64_v4i16((LAS s16x4*)p1));
    return (bf16x8){a[0], a[1], a[2], a[3], b[0], b[1], b[2], b[3]};
}
#define LDS_BARRIER() do { asm volatile("s_waitcnt lgkmcnt(0)" ::: "memory"); __builtin_amdgcn_s_barrier(); asm volatile("" ::: "memory"); } while (0)
#define MFMA16(X, Y, C) __builtin_amdgcn_mfma_f32_16x16x32_bf16((X), (Y), (C), 0, 0, 0)


struct HgRegs { unsigned lf[8], q[8]; v4u v[2]; };
template <bool WANT_Q> __device__ __forceinline__ void hg_issue(Frame& F, HgRegs& R, int u) {
    const int bh = u >> 7, c = u & 127, b = bh >> 3, h = bh & 7, dp = F.tid & 63, grp = F.tid >> 6;
    const bf16* P = F_P16 + (size_t)(b * SEQ + 64 * c) * P16S + h * HD;
#pragma unroll
    for (int j = 0; j < 8; ++j) { const bf16* src = P + (size_t)(8 * grp + j) * P16S + 2 * dp;
        R.lf[j] = *(const GAS unsigned*)(src + 1024); if (WANT_Q) R.q[j] = *(const GAS unsigned*)(src); }
#pragma unroll
    for (int i = 0; i < 2; ++i) { const int ch = F.tid + 512 * i, r = ch >> 4, cc = ch & 15; R.v[i] = *(const GAS v4u*)(P + (size_t)r * P16S + 2048 + cc * 8); }
}
__device__ __forceinline__ void hgrn2_a1_all(Frame& F) {
    constexpr int SET = 64 * VR * 2 + 8 * 128 * 2;
    const int dp = F.tid & 63, grp = F.tid >> 6, g = F.lane >> 4, li = F.lane & 15;
    HgRegs R; int u = F.vcu, par = 0;
    if (u < HG_UNITS) hg_issue<false>(F, R, u);
    while (u < HG_UNITS) {
        LAS unsigned short* Lk = (LAS unsigned short*)(F.lds) + par * SET;
        LAS unsigned short* Lv = Lk + 64 * VR;
        LAS float* Ltot = (LAS float*)(Lv + 64 * VR);
        float bl0[8], bl1[8]; { float r0 = 0.f, r1 = 0.f;
#pragma unroll
            for (int j = 0; j < 8; ++j) { r0 += h2f((unsigned short)(R.lf[j] & 0xffffu)); r1 += h2f((unsigned short)(R.lf[j] >> 16)); bl0[j] = r0; bl1[j] = r1; }
            *(LAS f32x2*)(Ltot + grp * 128 + 2 * dp) = (f32x2){r0, r1}; }
#pragma unroll
        for (int i = 0; i < 2; ++i) { const int ch = F.tid + 512 * i, r = ch >> 4, cc = ch & 15; *(LAS v4u*)(Lv + r * VR + cc * 8) = R.v[i]; }
        LDS_BARRIER();
        { float off0 = 0.f, off1 = 0.f, tot0 = 0.f, tot1 = 0.f;
#pragma unroll
          for (int gg = 0; gg < 8; ++gg) { const f32x2 t = *(const LAS f32x2*)(Ltot + gg * 128 + 2 * dp); if (gg < grp) { off0 += t.x; off1 += t.y; } tot0 += t.x; tot1 += t.y; }
#pragma unroll
          for (int j = 0; j < 8; ++j) { const float k0 = 1.0f - __expf(h2f((unsigned short)(R.lf[j] & 0xffffu))), k1 = 1.0f - __expf(h2f((unsigned short)(R.lf[j] >> 16)));
              *(LAS unsigned*)(Lk + (8 * grp + j) * VR + 2 * dp) = pk2(k0 * __expf(tot0 - (bl0[j] + off0)), k1 * __expf(tot1 - (bl1[j] + off1))); }
          if (grp == 0) *(GAS f32x2*)((float*)(F.ws + WS_DEC) + (size_t)u * 128 + 2 * dp) = (f32x2){__expf(tot0), __expf(tot1)}; }
        LDS_BARRIER();
        const int un = u + F.G;
        if (un < HG_UNITS) hg_issue<false>(F, R, un);
        { const LAS unsigned short* xb = Lk + (4 * g + (li >> 2)) * VR + 16 * F.wave + 4 * (li & 3);
          const LAS unsigned short* yb = Lv + (4 * g + (li >> 2)) * VR + 4 * (li & 3);
          const bf16x8 X0 = tr_frag(xb, xb + 16 * VR), X1 = tr_frag(xb + 32 * VR, xb + 48 * VR);
          bf16* so = (bf16*)(F.ws + WS_SLOC) + (size_t)u * 16384 + 16 * F.wave + 4 * g;
#pragma unroll
          for (int eb = 0; eb < 8; ++eb) { const bf16x8 Y0 = tr_frag(yb + 16 * eb, yb + 16 * eb + 16 * VR), Y1 = tr_frag(yb + 16 * eb + 32 * VR, yb + 16 * eb + 48 * VR);
              f32x4 acc = {0.f, 0.f, 0.f, 0.f}; acc = MFMA16(X0, Y0, acc); acc = MFMA16(X1, Y1, acc);
              v2u w; w.x = pk2(acc[0], acc[1]); w.y = pk2(acc[2], acc[3]);
              *(GAS v2u*)(so + (size_t)(16 * eb + li) * 128) = w; } }
        u = un; par ^= 1;
    }
    LDS_BARRIER();
}
__device__ __forceinline__ void hgrn2_a2(Frame& F) {
    const int NGW = F.G * NWAVES;
    for (int row = F.vcu * NWAVES + F.wave; row < BATCH * NH * 128; row += NGW) {
        const int bh = row >> 7, e = row & 127;
        const GAS unsigned* base = (const GAS unsigned*)(F.ws + WS_SLOC) + ((size_t)bh * 128 * 128 + e) * 64 + F.lane;
        GAS unsigned* obase = (GAS unsigned*)(F.ws + WS_SPREV) + ((size_t)bh * 128 * 128 + e) * 64 + F.lane;
        const GAS f32x2* dbase = (const GAS f32x2*)(F.ws + WS_DEC) + (size_t)bh * 128 * 64 + F.lane;
        float S0 = 0.f, S1 = 0.f;
        for (int c0 = 0; c0 < 128; c0 += 32) {
            unsigned loc[32]; f32x2 dc[32];
#pragma unroll
            for (int j = 0; j < 32; ++j) { loc[j] = __builtin_nontemporal_load(base + (size_t)(c0 + j) * 8192); dc[j] = dbase[(c0 + j) * 64]; }
#pragma unroll
            for (int j = 0; j < 32; ++j) { obase[(size_t)(c0 + j) * 8192] = pk2(S0, S1); S0 = dc[j].x * S0 + bflo(loc[j]); S1 = dc[j].y * S1 + bfhi(loc[j]); }
        }
    }
}

__device__ __forceinline__ void hgrn2_a3_all(Frame& F, const Args& args, int layer) {
    LAS unsigned short* Lq = (LAS unsigned short*)(F.lds);
    LAS unsigned short* Lk = Lq + 64 * TS;
    LAS unsigned short* Li = Lk + 64 * TS;
    LAS unsigned short* Lv = Li + 64 * TS;
    LAS unsigned short* LP = Lv + 64 * VR;
    LAS float* Lo = (LAS float*)(LP + 64 * VS);
    LAS float* Ltot = Lo + 64 * 132;
    const int dp = F.tid & 63, grp = F.tid >> 6, g = F.lane >> 4, li = F.lane & 15;
    HgRegs R; bf16x8 Spn[4]; unsigned gate[8]; f32x2 ogn; int u = F.vcu;
#define A3_ISSUE(uu) do { hg_issue<true>(F, R, (uu)); const int bh_ = (uu) >> 7, c_ = (uu) & 127; \
        const bf16* sp_ = (const bf16*)(F.ws + WS_SPREV) + (size_t)(uu) * 16384 + (size_t)(16 * F.wave + li) * 128 + 8 * g; \
        _Pragma("unroll") for (int kd = 0; kd < 4; ++kd) Spn[kd] = *(const GAS bf16x8*)(sp_ + 32 * kd); \
        const bf16* gp_ = F_P16 + (size_t)((bh_ >> 3) * SEQ + 64 * c_ + 8 * F.wave) * P16S + 3072 + (bh_ & 7) * HD + 2 * F.lane; \
        _Pragma("unroll") for (int rr = 0; rr < 8; ++rr) gate[rr] = *(const GAS unsigned*)(gp_ + (size_t)rr * P16S); \
        ogn = *(const GAS f32x2*)(F_hg_out_g + layer * HGW + (bh_ & 7) * HD + 2 * F.lane); } while (0)
    if (u < HG_UNITS) A3_ISSUE(u);
    while (u < HG_UNITS) {
        const int bh = u >> 7, c = u & 127, b = bh >> 3, h = bh & 7;
        const size_t row0 = (size_t)(b * SEQ + 64 * c);
        float bl0[8], bl1[8]; { float r0 = 0.f, r1 = 0.f;
#pragma unroll
            for (int j = 0; j < 8; ++j) { r0 += h2f((unsigned short)(R.lf[j] & 0xffffu)); r1 += h2f((unsigned short)(R.lf[j] >> 16)); bl0[j] = r0; bl1[j] = r1; }
            *(LAS f32x2*)(Ltot + grp * 128 + 2 * dp) = (f32x2){r0, r1}; }
#pragma unroll
        for (int i = 0; i < 2; ++i) { const int ch = F.tid + 512 * i, r = ch >> 4, cc = ch & 15; *(LAS v4u*)(Lv + r * VR + cc * 8) = R.v[i]; }
        LDS_BARRIER();
        { float off0 = 0.f, off1 = 0.f, ref0 = 0.f, ref1 = 0.f;
#pragma unroll
          for (int gg = 0; gg < 7; ++gg) { const f32x2 t = *(const LAS f32x2*)(Ltot + gg * 128 + 2 * dp); if (gg < grp) { off0 += t.x; off1 += t.y; } if (gg < 4) { ref0 += t.x; ref1 += t.y; } }
#pragma unroll
          for (int j = 0; j < 8; ++j) { const int s = 8 * grp + j; const float b0 = bl0[j] + off0, b1 = bl1[j] + off1; const float q0 = bflo(R.q[j]), q1 = bfhi(R.q[j]);
              *(LAS unsigned*)(Lq + s * TS + 2 * dp) = pk2(q0 * __expf(fminf(b0 - ref0, 80.f)), q1 * __expf(fminf(b1 - ref1, 80.f)));
              const float k0 = 1.0f - __expf(h2f((unsigned short)(R.lf[j] & 0xffffu))), k1 = 1.0f - __expf(h2f((unsigned short)(R.lf[j] >> 16)));
              *(LAS unsigned*)(Lk + s * TS + 2 * dp) = pk2(k0 * __expf(fminf(ref0 - b0, 80.f)), k1 * __expf(fminf(ref1 - b1, 80.f)));
              *(LAS unsigned*)(Li + s * TS + 2 * dp) = pk2(q0 * __expf(b0), q1 * __expf(b1)); } }
        bf16x8 Sp[4]; unsigned gw[8];
#pragma unroll
        for (int kd = 0; kd < 4; ++kd) Sp[kd] = Spn[kd];
#pragma unroll
        for (int rr = 0; rr < 8; ++rr) gw[rr] = gate[rr];
        const f32x2 og = ogn;
        LDS_BARRIER();
        const int un = u + F.G;
        if (un < HG_UNITS) A3_ISSUE(un);
#pragma unroll
        for (int k2 = 0; k2 < 2; ++k2) { const int id = 2 * F.wave + k2, si = id >> 2, ti = id & 3;
            f32x4 acc = {0.f, 0.f, 0.f, 0.f};
            if (si <= ti) {
#pragma unroll
                for (int kd = 0; kd < 4; ++kd) { const bf16x8 X = *(const LAS bf16x8*)(Lk + (16 * si + li) * TS + 32 * kd + 8 * g), Y = *(const LAS bf16x8*)(Lq + (16 * ti + li) * TS + 32 * kd + 8 * g);
                    acc = MFMA16(X, Y, acc); }
                const int t = 16 * ti + li, s0 = 16 * si + 4 * g;
#pragma unroll
                for (int r = 0; r < 4; ++r) acc[r] = (s0 + r <= t) ? acc[r] : 0.f; }
            v2u w; w.x = pk2(acc[0], acc[1]); w.y = pk2(acc[2], acc[3]);
            *(LAS v2u*)(LP + (16 * ti + li) * VS + 16 * si + 4 * g) = w; }
        LDS_BARRIER();
        { f32x4 acc[4];
#pragma unroll
          for (int ti = 0; ti < 4; ++ti) acc[ti] = (f32x4){0.f, 0.f, 0.f, 0.f};
          const LAS unsigned short* yb = Lv + (4 * g + (li >> 2)) * VR + 16 * F.wave + 4 * (li & 3);
#pragma unroll
          for (int ks = 0; ks < 2; ++ks) { const bf16x8 Y = tr_frag(yb + 32 * ks * VR, yb + (32 * ks + 16) * VR);
#pragma unroll
              for (int ti = 0; ti < 4; ++ti) { const LAS unsigned short* pp = LP + (16 * ti + li) * VS + 32 * ks + 4 * g; const v2u x0 = *(const LAS v2u*)(pp), x1 = *(const LAS v2u*)(pp + 16);
                  acc[ti] = MFMA16(__builtin_bit_cast(bf16x8, (v4u){x0.x, x0.y, x1.x, x1.y}), Y, acc[ti]); } }
#pragma unroll
          for (int kd = 0; kd < 4; ++kd) {
#pragma unroll
              for (int ti = 0; ti < 4; ++ti) { const bf16x8 X = *(const LAS bf16x8*)(Li + (16 * ti + li) * TS + 32 * kd + 8 * g); acc[ti] = MFMA16(X, Sp[kd], acc[ti]); } }
#pragma unroll
          for (int ti = 0; ti < 4; ++ti)
#pragma unroll
              for (int r = 0; r < 4; ++r) Lo[(16 * ti + 4 * g + r) * 132 + 16 * F.wave + li] = acc[ti][r]; }
        LDS_BARRIER();
        {
#pragma unroll
          for (int rr = 0; rr < 8; ++rr) { const int t = 8 * F.wave + rr; const size_t row = row0 + t;
              const f32x2 o = *(const LAS f32x2*)(Lo + t * 132 + 2 * F.lane);
              const float rstd = __builtin_amdgcn_rsqf(wave_sum(o.x * o.x + o.y * o.y) * (1.0f / HD) + EPS);
              *(GAS unsigned*)(F_MIX + row * DM + h * HD + 2 * F.lane) = pk2(o.x * rstd * og.x * bflo(gw[rr]), o.y * rstd * og.y * bfhi(gw[rr])); } }
        u = un;
    }
    LDS_BARRIER();
#undef A3_ISSUE
}

constexpr int AT_UNITS = BATCH * NH * (SEQ / 128);
constexpr float AT_STOP = 7.888609052210118e-31f;
struct AtRegs { v4u k[4], v[4]; };
__device__ __forceinline__ void at_issue(AtRegs& R, const bf16* Pb, int kb, int lr, int lc) {
#pragma unroll
    for (int i = 0; i < 4; ++i) { const bf16* src = Pb + (size_t)(128 * kb + lr + 32 * i) * P16S + lc * 8; R.k[i] = *(const GAS v4u*)(src + 5120); R.v[i] = *(const GAS v4u*)(src + 6144); }
}
__device__ __forceinline__ void at_half(Frame& F, int kb64, int hb, int tw, const LAS unsigned short* LKh, const LAS unsigned short* LVh, const bf16x8 (&Qf)[4], f32x4 (&O)[8], float& run) {
    const int g = F.lane >> 4, li = F.lane & 15, t = tw + li; const int kb = kb64; const LAS unsigned short* LK = LKh; const LAS unsigned short* LV = LVh;
    {
        float kp[4][4], sg[4][4];
#pragma unroll
        for (int sb = 0; sb < 4; ++sb) { f32x4 acc = {0.f, 0.f, 0.f, 0.f};
#pragma unroll
            for (int kd = 0; kd < 4; ++kd) { const bf16x8 X = *(const LAS bf16x8*)(LK + (16 * sb + li) * TS + 32 * kd + 8 * g); acc = MFMA16(X, Qf[kd], acc); }
#pragma unroll
            for (int r = 0; r < 4; ++r) { const float w = __builtin_amdgcn_exp2f(acc[r]); const float keep = __builtin_amdgcn_rcpf(1.0f + w);
                const bool valid = (64 * kb + 16 * sb + 4 * g + r) < t;
                kp[sb][r] = valid ? keep : 1.0f; sg[sb][r] = 1.0f - kp[sb][r]; } }
        float excl[4], TT[4], e1[4], e0[4];
#pragma unroll
        for (int sb = 0; sb < 4; ++sb) { e1[sb] = kp[sb][3] * kp[sb][2]; e0[sb] = e1[sb] * kp[sb][1]; const float T = e0[sb] * kp[sb][0];
            const float x1 = __shfl(T, (F.lane + 16) & 63), x2 = __shfl(T, (F.lane + 32) & 63), x3 = __shfl(T, (F.lane + 48) & 63);
            excl[sb] = (((g < 3) ? x1 : 1.0f) * ((g < 2) ? x2 : 1.0f)) * ((g < 1) ? x3 : 1.0f);
            TT[sb] = (T * ((g & 1) ? x3 : x1)) * (x2 * ((g & 1) ? x1 : x3)); }
        float off = run; bf16x8 X[2];
        { unsigned p[8];
#pragma unroll
          for (int sb = 3; sb >= 0; --sb) { const float base = off * excl[sb]; off *= TT[sb];
              const float a3 = base * sg[sb][3], a2 = base * kp[sb][3] * sg[sb][2], a1 = base * e1[sb] * sg[sb][1], a0 = base * e0[sb] * sg[sb][0];
              p[2 * sb] = pk2(a0, a1); p[2 * sb + 1] = pk2(a2, a3); }
          X[0] = __builtin_bit_cast(bf16x8, (v4u){p[0], p[1], p[2], p[3]}); X[1] = __builtin_bit_cast(bf16x8, (v4u){p[4], p[5], p[6], p[7]}); }
        run = off;
#pragma unroll
        for (int eb = 0; eb < 8; ++eb)
#pragma unroll
            for (int ks = 0; ks < 2; ++ks) { const LAS unsigned short* vp = LV + (32 * ks + 4 * g + (li >> 2)) * VR + 16 * eb + 4 * (li & 3);
                O[eb] = MFMA16(X[ks], tr_frag(vp, vp + 16 * VR), O[eb]); }
    }
}
__device__ __forceinline__ bool at_stage(Frame& F, AtRegs& R, const bf16* Pb, int kb, int tw, int lr, int lc, LAS unsigned short* LK, LAS unsigned short* LV, LAS unsigned* Lflag,
                                         const bf16x8 (&Qf)[4], f32x4 (&O)[8], float& run, bool& wdone, bool issue_next, AtRegs& Rn, v4u (&qn)[4], const bf16* Pbn, int tn, int qtn) {
    LDS_BARRIER();
    { unsigned all = 1u;
#pragma unroll
      for (int w = 0; w < 8; ++w) all &= Lflag[w];
      if (__builtin_amdgcn_readfirstlane(all)) return true; }
#pragma unroll
    for (int i = 0; i < 4; ++i) { const int r = lr + 32 * i; const unsigned ka[4] = {R.k[i].x, R.k[i].y, R.k[i].z, R.k[i].w}; float kv[8]; float ss = 0.f;
#pragma unroll
        for (int j = 0; j < 4; ++j) { kv[2 * j] = bflo(ka[j]); kv[2 * j + 1] = bfhi(ka[j]); ss += kv[2 * j] * kv[2 * j] + kv[2 * j + 1] * kv[2 * j + 1]; }
        ss = row16_sum(ss);
        const float rk = __builtin_amdgcn_rsqf(ss * (1.0f / HD) + EPS);
        *(LAS v4u*)(LK + r * TS + lc * 8) = (v4u){pk2(kv[0] * rk, kv[1] * rk), pk2(kv[2] * rk, kv[3] * rk), pk2(kv[4] * rk, kv[5] * rk), pk2(kv[6] * rk, kv[7] * rk)};
        *(LAS v4u*)(LV + r * VR + lc * 8) = R.v[i]; }
    LDS_BARRIER();
    at_issue(R, Pb, (kb >= 1) ? (kb - 1) : 0, lr, lc);
    if (issue_next) {
        const int g_ = F.lane >> 4;
#pragma unroll
        for (int kd = 0; kd < 4; ++kd) qn[kd] = *(const GAS v4u*)(Pbn + (size_t)tn * P16S + 4096 + 32 * kd + 8 * g_);
        at_issue(Rn, Pbn, qtn, lr, lc); }
    if (!wdone && (128 * kb + 64 <= tw + 14)) { at_half(F, 2 * kb + 1, 1, tw, LK + 64 * TS, LV + 64 * VR, Qf, O, run); wdone = __all(run < AT_STOP); }
    if (!wdone && (128 * kb <= tw + 14)) { at_half(F, 2 * kb, 0, tw, LK, LV, Qf, O, run); wdone = __all(run < AT_STOP); }
    if (kb == 0) wdone = true;
    if (wdone && F.lane == 0) Lflag[F.wave] = 1u;
    return false;
}
__device__ __forceinline__ void attn_all(Frame& F, const Args& args, int layer) {
    LAS unsigned short* LK = (LAS unsigned short*)(F.lds);
    LAS unsigned short* LV = LK + 128 * TS;
    LAS unsigned* Lflag = (LAS unsigned*)(LV + 128 * VR);
    LAS float* Lo = (LAS float*)(F.lds) + F.wave * (16 * 132);
    const int g = F.lane >> 4, li = F.lane & 15, lr = F.tid >> 4, lc = F.tid & 15;
    LAS float* Lgqk = (LAS float*)(Lflag + 16); LAS float* Log = Lgqk + 128;
    if (F.tid < 128) Lgqk[F.tid] = F_sb_q_g[layer * HD + F.tid] * F_sb_k_g[layer * HD + F.tid] * (0.08838834764831845f * 1.4426950408889634f);
    for (int i = F.tid; i < HGW; i += NWAVES * 64) Log[i] = F_sb_out_g[layer * HGW + i];
    LDS_BARRIER();
    AtRegs R0, Rn; v4u qraw[4], qn[4];
    int u = F.vcu;
    if (u < AT_UNITS) { const int bh_ = u >> 6, qt_ = u & 63; const bf16* Pb_ = F_P16 + (size_t)((bh_ >> 3) * SEQ) * P16S + (bh_ & 7) * HD; const int t_ = 128 * qt_ + 16 * F.wave + li;
#pragma unroll
        for (int kd = 0; kd < 4; ++kd) qraw[kd] = *(const GAS v4u*)(Pb_ + (size_t)t_ * P16S + 4096 + 32 * kd + 8 * g);
        at_issue(R0, Pb_, qt_, lr, lc); }
    while (u < AT_UNITS) {
        const int bh = u >> 6, qt = u & 63, b = bh >> 3, h = bh & 7, t0 = 128 * qt, tw = t0 + 16 * F.wave;
        const bf16* Pb = F_P16 + (size_t)(b * SEQ) * P16S + h * HD;
        const int un = u + F.G; const bool has_next = un < AT_UNITS;
        const int bhn = has_next ? (un >> 6) : bh, qtn = has_next ? (un & 63) : qt; const bf16* Pbn = F_P16 + (size_t)((bhn >> 3) * SEQ) * P16S + (bhn & 7) * HD; const int tn = 128 * qtn + 16 * F.wave + li;
        bf16x8 Qf[4];
        { float qv[32]; float ss = 0.f;
#pragma unroll
          for (int kd = 0; kd < 4; ++kd) { const unsigned a[4] = {qraw[kd].x, qraw[kd].y, qraw[kd].z, qraw[kd].w};
#pragma unroll
              for (int j = 0; j < 4; ++j) { const float lo = bflo(a[j]), hi = bfhi(a[j]); qv[8 * kd + 2 * j] = lo; qv[8 * kd + 2 * j + 1] = hi; ss += lo * lo + hi * hi; } }
          ss += __shfl_xor(ss, 16); ss += __shfl_xor(ss, 32);
          const float rq = __builtin_amdgcn_rsqf(ss * (1.0f / HD) + EPS);
#pragma unroll
          for (int kd = 0; kd < 4; ++kd) { unsigned p[4];
              const f32x4 c0 = *(const LAS f32x4*)(Lgqk + 32 * kd + 8 * g), c1 = *(const LAS f32x4*)(Lgqk + 32 * kd + 8 * g + 4); const float cc[8] = {c0.x, c0.y, c0.z, c0.w, c1.x, c1.y, c1.z, c1.w};
#pragma unroll
              for (int j = 0; j < 4; ++j) p[j] = pk2(qv[8 * kd + 2 * j] * rq * cc[2 * j], qv[8 * kd + 2 * j + 1] * rq * cc[2 * j + 1]);
              Qf[kd] = __builtin_bit_cast(bf16x8, (v4u){p[0], p[1], p[2], p[3]}); } }
        float run = 1.0f;
        f32x4 O[8];
#pragma unroll
        for (int eb = 0; eb < 8; ++eb) O[eb] = (f32x4){0.f, 0.f, 0.f, 0.f};
        bool wdone = false, issued = false;
        if (F.tid < 8) Lflag[F.tid] = 0u;
        for (int kb = qt; kb >= 0; --kb) {
            const bool inow = has_next && !issued && (kb == qt - 1 || kb == 0);
            if (at_stage(F, R0, Pb, kb, tw, lr, lc, LK, LV, Lflag, Qf, O, run, wdone, inow, Rn, qn, Pbn, tn, qtn)) break;
            issued = issued || inow;
        }
        LDS_BARRIER();
        if (has_next && !issued) {
#pragma unroll
            for (int kd = 0; kd < 4; ++kd) qn[kd] = *(const GAS v4u*)(Pbn + (size_t)tn * P16S + 4096 + 32 * kd + 8 * g);
            at_issue(Rn, Pbn, qtn, lr, lc); }
#pragma unroll
        for (int eb = 0; eb < 8; ++eb)
#pragma unroll
            for (int r = 0; r < 4; ++r) Lo[(4 * g + r) * 132 + 16 * eb + li] = O[eb][r];
        LDS_WAIT(); asm volatile("" ::: "memory");
        { const int rr = F.lane >> 2, es = 32 * (F.lane & 3); f32x4 ov[8]; float ss = 0.f;
#pragma unroll
          for (int i = 0; i < 8; ++i) { ov[i] = *(const LAS f32x4*)(Lo + rr * 132 + es + 4 * i); ss += (ov[i].x * ov[i].x + ov[i].y * ov[i].y) + (ov[i].z * ov[i].z + ov[i].w * ov[i].w); }
          ss = quad_sum(ss);
          const float ro = __builtin_amdgcn_rsqf(ss * (1.0f / HD) + EPS);
          GAS v4u* op = (GAS v4u*)(F_MIX + (size_t)(b * SEQ + tw + rr) * DM + HGW + h * HD + es);
#pragma unroll
          for (int i = 0; i < 4; ++i) { const f32x4 a0 = ov[2 * i] * ro * *(const LAS f32x4*)(Log + h * HD + es + 8 * i), a1 = ov[2 * i + 1] * ro * *(const LAS f32x4*)(Log + h * HD + es + 8 * i + 4);
              op[i] = (v4u){pk2(a0.x, a0.y), pk2(a0.z, a0.w), pk2(a1.x, a1.y), pk2(a1.z, a1.w)}; } }
        LDS_BARRIER();
#pragma unroll
        for (int kd = 0; kd < 4; ++kd) qraw[kd] = qn[kd];
        R0 = Rn;
        u = un;
    }
}
__global__ void __launch_bounds__(NWAVES * 64, 2) skel_fwd(Args args) {
    extern __shared__ __attribute__((aligned(16))) unsigned char lds[];
    Frame F;
    F.lds = (LAS unsigned char*)lds;
    F.MISC = (volatile LAS unsigned*)(F.lds + MISC_OFF);
    F.tid = threadIdx.x; F.lane = F.tid & 63; F.wave = __builtin_amdgcn_readfirstlane(F.tid >> 6);
    F.G = gridDim.x; { const int bx = blockIdx.x; F.vcu = (F.G % 8 == 0) ? (bx % 8) * (F.G / 8) + bx / 8 : bx; }
    unsigned char* ws = args.ws; F.ws = ws; F.out = args.out;
    F.ctl = (gu32*)(ws + WS_CTL);
    for (int u = F.tid; u < (LDS_BYTES - LDSCTL_OFF) / 4; u += NWAVES * 64) ((LAS unsigned*)(F.lds + LDSCTL_OFF))[u] = 0u;
    __syncthreads();
    XcdBarrier bar; bar.bar = (unsigned*)(F.ctl + CW_BAR); bar.x = 0; bar.st = nullptr;
    if (!MK_PER_PHASE) bar = xcd_barrier_post((unsigned*)(F.ctl + CW_BAR), F.MISC + 8);
#define GRID_BAR(seam) do { if (MK_PER_PHASE) { if (F.tid == 0) __hip_atomic_store(F.ctl + CW_TMO, 0xBADBA0u | (unsigned)(seam), RLX_AGENT); } else { XcdBarrier b_ = bar; unsigned* p_ = b_.bar; asm volatile("" : "+s"(p_)); b_.bar = p_; xcd_barrier(b_); } } while (0)
    const int lo = args.ph_lo, hi = args.ph_hi;
#define IN(k) (lo <= (k) && (k) < hi)
#define BOTH(k) (IN(k) && IN((k) + 1))

    if (IN(0)) { PHASE_FRAME(Fl); p0_prologue_a(Fl, args); if (BOTH(0)) GRID_BAR(0); }
    if (IN(1)) { PHASE_FRAME(Fl); p0_prologue_b(Fl, args); if (BOTH(1)) GRID_BAR(1); }
    if (IN(2)) { PHASE_FRAME(Fl); norm0_phase(Fl, F_x, F_norm1_g, F_MOD, DM, (long long*)(ws + WS_SS));
        { constexpr int NC = DEPTH * BATCH * (INC + 2 * DFF); const long long* cfx = (const long long*)(ws + WS_C1); float* cf = (float*)(ws + WS_CF);
          for (int i = Fl.vcu * (NWAVES * 64) + Fl.tid; i < NC; i += Fl.G * NWAVES * 64) cf[i] = pg8::fx_get(cfx + i, pg8::C_INV); }
        if (BOTH(2)) GRID_BAR(2); }

    for (int l = 0; l < DEPTH; ++l) {
        const int p0 = 3 + NPL * l;
        const float* xin = (l == 0) ? F_x : F.out;
        bf16* xa = (bf16*)(ws + WS_XA);
        const float* modl = F_MOD + (size_t)l * 2 * NMODC;
        const unsigned char* wt = ws + WS_WT + (size_t)l * WT_LAYER;
        long long* ss1 = (long long*)(ws + WS_SS) + (size_t)(2 * l) * M; long long* ss2 = ss1 + M;
        if (IN(p0 + 0)) {
            pg8::Gemm g{F_H, (const bf16*)(wt + WT_IN), M, INC, DM}; pg8::StaticOrder S; S.init(M, INC, F.G, (int)blockIdx.x);
            pg8::EpiProj E{F_P16, F_LB + l * HGW, ss1, (const float*)(ws + WS_CF) + (size_t)l * BATCH * INC, INC, SEQ};
            pg8::gemm_phase<pg8::EpiProj, pg8::StaticOrder, true, true>(F.lds + RING_OFF, g, S, E);
            if (BOTH(p0 + 0)) GRID_BAR(p0 + 0);
        }
        if (IN(p0 + 1)) {
            PHASE_FRAME(Fl);
            hgrn2_a1_all(Fl);
            attn_all(Fl, args, l);
            if (BOTH(p0 + 1)) GRID_BAR(p0 + 1);
        }
        if (IN(p0 + 2)) { PHASE_FRAME(Fl); hgrn2_a2(Fl); if (BOTH(p0 + 2)) GRID_BAR(p0 + 2); }
        if (IN(p0 + 3)) {
            PHASE_FRAME(Fl);
            hgrn2_a3_all(Fl, args, l);
            if (BOTH(p0 + 3)) GRID_BAR(p0 + 3);
        }
        if (IN(p0 + 4)) {
            pg8::Gemm g{F_MIX, (const bf16*)(wt + WT_OUT), M, DM, DM}; pg8::StaticOrder S; S.init(M, DM, F.G, (int)blockIdx.x);
            pg8::EpiResid<true, false> E{xin, nullptr, xa, modl + 2 * DM, NMODC, SEQ, F_H, F_norm2_g + l * DM, modl + 4 * DM, ss2};
            pg8::gemm_phase<pg8::EpiResid<true, false>, pg8::StaticOrder, false, true>(F.lds + RING_OFF, g, S, E);
            if (BOTH(p0 + 4)) GRID_BAR(p0 + 4);
        }
        if (IN(p0 + 5)) {
            pg8::Gemm g{F_H, (const bf16*)(wt + WT_FI), M, 2 * DFF, DM}; pg8::StaticOrder S; S.init(M, 2 * DFF, F.G, (int)blockIdx.x);
            pg8::EpiSwiGLU E{F_HID, DFF, ss2, (const float*)(ws + WS_CF) + (size_t)DEPTH * BATCH * INC + (size_t)l * BATCH * 2 * DFF, 2 * DFF, SEQ};
            pg8::gemm_phase<pg8::EpiSwiGLU, pg8::StaticOrder, true, true>(F.lds + RING_OFF, g, S, E);
            if (BOTH(p0 + 5)) GRID_BAR(p0 + 5);
        }
        if (IN(p0 + 6)) {
            pg8::Gemm g{F_HID, (const bf16*)(wt + WT_FO), M, DM, DFF}; pg8::StaticOrder S; S.init(M, DM, F.G, (int)blockIdx.x);
            const bool nxt = (l + 1 < DEPTH);
            pg8::EpiResid<false, true> E{xin, F.out, xa, modl + 5 * DM, NMODC, SEQ, nxt ? F_H : nullptr, F_norm1_g + (nxt ? l + 1 : l) * DM, F_MOD + (size_t)(nxt ? l + 1 : l) * 2 * NMODC + DM, nxt ? ss2 + M : ss2};
            pg8::gemm_phase<pg8::EpiResid<false, true>, pg8::StaticOrder, false, true>(F.lds + RING_OFF, g, S, E);
            if (BOTH(p0 + 6)) GRID_BAR(p0 + 6);
        }
    }
#undef IN
#undef BOTH
}

extern "C" void kernel_launch(void* const* d_in, const int* in_sizes, int n_in, void* d_out, int out_size, void* d_ws, size_t ws_size, hipStream_t stream) {
    static int grid = 0;
    if (grid == 0) {
        if (n_in != 15 || in_sizes[0] != M * DM || out_size != M * DM || ws_size < WS_END) { fprintf(stderr, "kernel_launch: unexpected shapes (n_in %d, in0 %d, out %d, ws %zu < %zu); nothing launched\n", n_in, n_in > 0 ? in_sizes[0] : -1, out_size, ws_size, (size_t)WS_END); grid = -1; return; }
        int dev = 0, cus = 0, per_cu = 0;
        if (hipGetDevice(&dev) != hipSuccess || hipDeviceGetAttribute(&cus, hipDeviceAttributeMultiprocessorCount, dev) != hipSuccess) { grid = -1; return; }
        if (hipFuncSetAttribute((const void*)skel_fwd, hipFuncAttributeMaxDynamicSharedMemorySize, LDS_BYTES) != hipSuccess) { fprintf(stderr, "kernel_launch: hipFuncSetAttribute failed\n"); grid = -1; return; }
        if (hipOccupancyMaxActiveBlocksPerMultiprocessor(&per_cu, (const void*)skel_fwd, NWAVES * 64, LDS_BYTES) != hipSuccess || per_cu < 1)
            fprintf(stderr, "kernel_launch: note: occupancy query reports %d workgroups per CU\n", per_cu);
        (void)hipGetLastError();
        grid = cus;
        if (grid > 256) grid = 256;
    }
    if (grid < 0) return;
    if (hipMemsetAsync((char*)d_ws + WS_CTL, 0, CTL_ZERO_BYTES, stream) != hipSuccess) return;
    Args a{};
    for (int i = 0; i < 15; ++i) a.in[i] = (const float*)d_in[i];
    a.out = (float*)d_out; a.ws = (unsigned char*)d_ws; a.li = 0; a.pad = 0;
#if MK_PER_PHASE
    for (int p = 0; p < NPH; ++p) { a.ph_lo = p; a.ph_hi = p + 1; hipLaunchKernelGGL(skel_fwd, dim3(grid), dim3(NWAVES * 64), LDS_BYTES, stream, a); }
#else
    a.ph_lo = 0; a.ph_hi = NPH;
    hipLaunchKernelGGL(skel_fwd, dim3(grid), dim3(NWAVES * 64), LDS_BYTES, stream, a);
#endif
}
```

```cpp
#include <hip/hip_runtime.h>
#include <cstdio>
#include <cstdint>
namespace pg8 {
#define PG8_LAS __attribute__((address_space(3)))
typedef unsigned short bf16_t;
typedef short bf16x8 __attribute__((ext_vector_type(8)));
typedef float f32x4 __attribute__((ext_vector_type(4)));
typedef unsigned u32x4 __attribute__((ext_vector_type(4)));
constexpr int BM = 256, BK = 64, HALF = 128, HTB = HALF * BK * 2  , STAGE_BYTES = 8 * HTB, NXCD = 8, WGM = 8;

__host__ __device__ __forceinline__ int lds_byte(int r, int c) { const int st = (r >> 4) * 2 + (c >> 5), rr = r & 15, cc = c & 31, ob = rr * 64 + cc * 2; return st * 1024 + (ob ^ (((ob >> 9) & 1) << 5)); }
__host__ __device__ __forceinline__ void stage_rc(int b, int& R, int& C) { const int st = b / 1024, sb = b % 1024, swz = sb ^ (((sb >> 9) & 1) << 5); R = (st >> 1) * 16 + swz / 64; C = (st & 1) * 32 + (swz % 64) / 2; }
__host__ __device__ __forceinline__ int perm32(int rho) { const int n = rho >> 4, i = rho & 15; return 8 * (i >> 2) + 4 * n + (i & 3); }

struct Unit { int pm, pn; };
struct Gemm { const bf16_t* A; const bf16_t* Bt; int M, N, K; };

struct StaticOrder {
    int nM, nN, nwg, G, c;
    __host__ __device__ void init(int M, int N, int G_, int c_) { nM = M / BM; nN = N / BM; nwg = nM * nN; G = G_; c = c_; }
    __host__ __device__ bool next(int i, Unit& u) const {
        const long L = (long)i * G + c; if (L >= nwg) return false;
        int wgid = (int)L; { const int q = nwg / NXCD, r = nwg % NXCD, xcd = wgid % NXCD, off = wgid / NXCD; wgid = (xcd < r ? xcd * (q + 1) : r * (q + 1) + (xcd - r) * q) + off; }
        const int nig = WGM * nN, gid = wgid / nig, fm = gid * WGM, gsz = (nM - fm) < WGM ? (nM - fm) : WGM;
        u.pm = fm + ((wgid % nig) % gsz); u.pn = (wgid % nig) / gsz; return true;
    }
    __device__ __forceinline__ void a_ready(const Unit&) const {}
    __device__ __forceinline__ void done(const Unit&) const {}
};

__device__ __forceinline__ unsigned cvt_pk_bf16(float lo, float hi) { unsigned r; asm volatile("v_cvt_pk_bf16_f32 %0, %1, %2" : "=v"(r) : "v"(lo), "v"(hi)); return r; }
__device__ __forceinline__ unsigned cvt_pk_f16(float lo, float hi) { typedef _Float16 h2 __attribute__((ext_vector_type(2))); h2 v; v.x = (_Float16)lo; v.y = (_Float16)hi; return __builtin_bit_cast(unsigned, v); }
__device__ __forceinline__ float fsilu(float x) { return x * __builtin_amdgcn_rcpf(1.0f + __expf(-x)); }
__device__ __forceinline__ f32x4 fsilu4(f32x4 x) {
    f32x4 e = x * -1.4426950408889634f;
#pragma unroll
    for (int j = 0; j < 4; ++j) e[j] = __builtin_amdgcn_exp2f(e[j]);
    f32x4 d = e + 1.0f;
#pragma unroll
    for (int j = 0; j < 4; ++j) d[j] = __builtin_amdgcn_rcpf(d[j]);
    return x * d;
}

constexpr int P16_LD = 8192;
constexpr float RMS_EPS = 1e-6f;
__device__ __forceinline__ void fx_add(long long* p, float v, float scale) { atomicAdd((unsigned long long*)p, (unsigned long long)__float2ll_rn(v * scale)); }
__device__ __forceinline__ float fx_get(const long long* p, float inv_scale) { return (float)(*p) * inv_scale; }
constexpr float SS_SCALE = 65536.0f, SS_INV = 1.0f / 65536.0f, C_SCALE = 4294967296.0f, C_INV = 1.0f / 4294967296.0f;
struct EpiProj {
    static constexpr bool PERM = true, AFTER_DRAIN = false;
    bf16_t* P; const float* lb;
    const long long* ss; const float* cvec; int cstride, rows_per_batch;
    __device__ __forceinline__ void operator()(const f32x4 (&acc)[2][2][4][2], const Unit& u, int wr, int wc, int fr, int fq) const {
        const int sec = u.pn >> 2;
        const int row0 = u.pm * BM + wr * 64 + fr, col0 = u.pn * BM + wc * 32 + 8 * fq;
        const float* cb = cvec + (size_t)((u.pm * BM) / rows_per_batch) * cstride + col0;
        const float* lbp = lb + ((sec == 1) ? (col0 - 1024) : 0);
        long long sv[2][4]; f32x4 cc[2][2], ll[2][2];
#pragma unroll
        for (int ai = 0; ai < 2; ++ai)
#pragma unroll
            for (int m = 0; m < 4; ++m) sv[ai][m] = ss[row0 + ai * HALF + m * 16];
#pragma unroll
        for (int bj = 0; bj < 2; ++bj) { cc[bj][0] = *(const f32x4*)(cb + bj * HALF); cc[bj][1] = *(const f32x4*)(cb + bj * HALF + 4);
            ll[bj][0] = *(const f32x4*)(lbp + bj * HALF); ll[bj][1] = *(const f32x4*)(lbp + bj * HALF + 4); }
        asm volatile("" : "+v"(sv[0][0]), "+v"(sv[0][1]), "+v"(sv[0][2]), "+v"(sv[0][3]), "+v"(sv[1][0]), "+v"(sv[1][1]), "+v"(sv[1][2]), "+v"(sv[1][3]),
                          "+v"(cc[0][0]), "+v"(cc[0][1]), "+v"(cc[1][0]), "+v"(cc[1][1]), "+v"(ll[0][0]), "+v"(ll[0][1]), "+v"(ll[1][0]), "+v"(ll[1][1]));
        float rstd[2][4];
#pragma unroll
        for (int ai = 0; ai < 2; ++ai)
#pragma unroll
            for (int m = 0; m < 4; ++m) rstd[ai][m] = __builtin_amdgcn_rsqf((float)sv[ai][m] * (SS_INV * (1.0f / 2048.0f)) + RMS_EPS);
#pragma unroll
        for (int bj = 0; bj < 2; ++bj) {
            const f32x4 c0 = cc[bj][0], c1 = cc[bj][1];
            if (sec == 1) {
                const f32x4 l0 = ll[bj][0], l1 = ll[bj][1];
#pragma unroll
                for (int ai = 0; ai < 2; ++ai)
#pragma unroll
                    for (int m = 0; m < 4; ++m) { bf16_t* rowp = P + (size_t)(row0 + ai * HALF + m * 16) * P16_LD + col0 + bj * HALF; float lf[8];
#pragma unroll
                        for (int j = 0; j < 4; ++j) { const float fl0 = acc[ai][bj][m][0][j] * rstd[ai][m] + c0[j], fl1 = acc[ai][bj][m][1][j] * rstd[ai][m] + c1[j];
                            const float r0 = __builtin_amdgcn_rcpf(1.0f + __expf(-fl0)), r1 = __builtin_amdgcn_rcpf(1.0f + __expf(-fl1));
                            lf[j] = 0.6931471805599453f * __builtin_amdgcn_logf(fmaxf(l0[j] + (1.0f - l0[j]) * r0, 1e-30f)); lf[4 + j] = 0.6931471805599453f * __builtin_amdgcn_logf(fmaxf(l1[j] + (1.0f - l1[j]) * r1, 1e-30f)); }
                        u32x4 w; w.x = cvt_pk_f16(lf[0], lf[1]); w.y = cvt_pk_f16(lf[2], lf[3]); w.z = cvt_pk_f16(lf[4], lf[5]); w.w = cvt_pk_f16(lf[6], lf[7]);
                        *(u32x4*)(rowp) = w; }
            } else {
                const bool act = (sec == 0) || (sec == 3);
#pragma unroll
                for (int ai = 0; ai < 2; ++ai)
#pragma unroll
                    for (int m = 0; m < 4; ++m) { bf16_t* rowp = P + (size_t)(row0 + ai * HALF + m * 16) * P16_LD + col0 + bj * HALF;
                        f32x4 v0 = acc[ai][bj][m][0] * rstd[ai][m] + c0, v1 = acc[ai][bj][m][1] * rstd[ai][m] + c1;
                        if (act) { v0 = fsilu4(v0); v1 = fsilu4(v1); }
                        u32x4 w; w.x = cvt_pk_bf16(v0[0], v0[1]); w.y = cvt_pk_bf16(v0[2], v0[3]); w.z = cvt_pk_bf16(v1[0], v1[1]); w.w = cvt_pk_bf16(v1[2], v1[3]);
                        *(u32x4*)(rowp) = w; }
            }
        }
    }
};
template <bool OUT_DELTA, bool HAS_DIN> struct EpiResid {
    static constexpr bool PERM = true, AFTER_DRAIN = false;
    const float* base; float* out; bf16_t* dbuf; const float* gate; int gate_bstride, rows_per_batch;
    bf16_t* Hn; const float* gnext; const float* scnext; long long* ssn;
    __device__ __forceinline__ void operator()(const f32x4 (&acc)[2][2][4][2], const Unit& u, int wr, int wc, int fr, int fq) const {
        const int row0 = u.pm * BM + wr * 64 + fr, col0 = u.pn * BM + wc * 32 + 8 * fq, b = (u.pm * BM) / rows_per_batch;
        const float* g = gate + (size_t)b * gate_bstride + col0;
        float ssq[2][4];
#pragma unroll
        for (int ai = 0; ai < 2; ++ai)
#pragma unroll
            for (int m = 0; m < 4; ++m) ssq[ai][m] = 0.f;
        f32x4 gv[2][2], Gv[2][2];
#pragma unroll
        for (int bj = 0; bj < 2; ++bj) { gv[bj][0] = *(const f32x4*)(g + bj * HALF); gv[bj][1] = *(const f32x4*)(g + bj * HALF + 4); Gv[bj][0] = (f32x4){0.f, 0.f, 0.f, 0.f}; Gv[bj][1] = (f32x4){0.f, 0.f, 0.f, 0.f};
            if (Hn) { const float* sc = scnext + (size_t)b * gate_bstride + col0 + bj * HALF;
                Gv[bj][0] = *(const f32x4*)(gnext + col0 + bj * HALF) * (1.0f + *(const f32x4*)(sc)); Gv[bj][1] = *(const f32x4*)(gnext + col0 + bj * HALF + 4) * (1.0f + *(const f32x4*)(sc + 4)); } }
#pragma unroll
        for (int bj = 0; bj < 2; ++bj) {
            const f32x4 g0 = gv[bj][0], g1 = gv[bj][1], G0 = Gv[bj][0], G1 = Gv[bj][1];
#pragma unroll
            for (int ai = 0; ai < 2; ++ai)
#pragma unroll
                for (int m = 0; m < 4; ++m) { const size_t off = (size_t)(row0 + ai * HALF + m * 16) * 2048 + col0 + bj * HALF;
                    f32x4 x0 = __builtin_nontemporal_load((const f32x4*)(base + off)), x1 = __builtin_nontemporal_load((const f32x4*)(base + off + 4));
                    if constexpr (HAS_DIN) { const u32x4 dw = __builtin_nontemporal_load((const u32x4*)(dbuf + off));
                        x0 += (f32x4){__builtin_bit_cast(float, dw.x << 16), __builtin_bit_cast(float, dw.x & 0xffff0000u), __builtin_bit_cast(float, dw.y << 16), __builtin_bit_cast(float, dw.y & 0xffff0000u)};
                        x1 += (f32x4){__builtin_bit_cast(float, dw.z << 16), __builtin_bit_cast(float, dw.z & 0xffff0000u), __builtin_bit_cast(float, dw.w << 16), __builtin_bit_cast(float, dw.w & 0xffff0000u)}; }
                    f32x4 o0, o1;
                    if constexpr (OUT_DELTA) { const f32x4 d0 = g0 * acc[ai][bj][m][0], d1 = g1 * acc[ai][bj][m][1];
                        u32x4 w; w.x = cvt_pk_bf16(d0[0], d0[1]); w.y = cvt_pk_bf16(d0[2], d0[3]); w.z = cvt_pk_bf16(d1[0], d1[1]); w.w = cvt_pk_bf16(d1[2], d1[3]);
                        *(u32x4*)(dbuf + off) = w;
                        o0 = x0 + (f32x4){__builtin_bit_cast(float, w.x << 16), __builtin_bit_cast(float, w.x & 0xffff0000u), __builtin_bit_cast(float, w.y << 16), __builtin_bit_cast(float, w.y & 0xffff0000u)};
                        o1 = x1 + (f32x4){__builtin_bit_cast(float, w.z << 16), __builtin_bit_cast(float, w.z & 0xffff0000u), __builtin_bit_cast(float, w.w << 16), __builtin_bit_cast(float, w.w & 0xffff0000u)}; }
                    else { o0 = x0 + g0 * acc[ai][bj][m][0]; o1 = x1 + g1 * acc[ai][bj][m][1]; *(f32x4*)(out + off) = o0; *(f32x4*)(out + off + 4) = o1; }
                    if (Hn) { const f32x4 h0 = o0 * G0, h1 = o1 * G1;
                        u32x4 w; w.x = cvt_pk_bf16(h0[0], h0[1]); w.y = cvt_pk_bf16(h0[2], h0[3]); w.z = cvt_pk_bf16(h1[0], h1[1]); w.w = cvt_pk_bf16(h1[2], h1[3]);
                        *(u32x4*)(Hn + off) = w;
                        ssq[ai][m] += ((o0[0] * o0[0] + o0[1] * o0[1]) + (o0[2] * o0[2] + o0[3] * o0[3])) + ((o1[0] * o1[0] + o1[1] * o1[1]) + (o1[2] * o1[2] + o1[3] * o1[3])); } }
            if (bj == 0) asm volatile("" ::: "memory");
        }
        if (Hn) {
#pragma unroll
            for (int ai = 0; ai < 2; ++ai)
#pragma unroll
                for (int m = 0; m < 4; ++m) { float s = ssq[ai][m]; s += __shfl_xor(s, 16); s += __shfl_xor(s, 32);
                    if (fq == 0) fx_add(ssn + row0 + ai * HALF + m * 16, s, SS_SCALE); } }
    }
};
struct EpiSwiGLU {
    static constexpr bool PERM = true, AFTER_DRAIN = false;
    bf16_t* Hd; int ldh;
    const long long* ss; const float* cvec; int cstride, rows_per_batch;
    __device__ __forceinline__ void operator()(const f32x4 (&acc)[2][2][4][2], const Unit& u, int wr, int wc, int fr, int fq) const {
        const int row0 = u.pm * BM + wr * 64 + fr, col0 = u.pn * HALF + wc * 32 + 8 * fq;
        const float* cb = cvec + (size_t)((u.pm * BM) / rows_per_batch) * cstride + u.pn * BM + wc * 32 + 8 * fq;
        long long sv[2][4];
#pragma unroll
        for (int ai = 0; ai < 2; ++ai)
#pragma unroll
            for (int m = 0; m < 4; ++m) sv[ai][m] = ss[row0 + ai * HALF + m * 16];
        f32x4 cg0 = *(const f32x4*)(cb), cg1 = *(const f32x4*)(cb + 4), cu0 = *(const f32x4*)(cb + HALF), cu1 = *(const f32x4*)(cb + HALF + 4);
        asm volatile("" : "+v"(sv[0][0]), "+v"(sv[0][1]), "+v"(sv[0][2]), "+v"(sv[0][3]), "+v"(sv[1][0]), "+v"(sv[1][1]), "+v"(sv[1][2]), "+v"(sv[1][3]), "+v"(cg0), "+v"(cg1), "+v"(cu0), "+v"(cu1));
#pragma unroll
        for (int ai = 0; ai < 2; ++ai)
#pragma unroll
            for (int m = 0; m < 4; ++m) { bf16_t* rowp = Hd + (size_t)(row0 + ai * HALF + m * 16) * ldh + col0;
                const float rstd = __builtin_amdgcn_rsqf((float)sv[ai][m] * (SS_INV * (1.0f / 2048.0f)) + RMS_EPS);
                const f32x4 ga = acc[ai][0][m][0] * rstd + cg0, gb = acc[ai][0][m][1] * rstd + cg1, ua = acc[ai][1][m][0] * rstd + cu0, ub = acc[ai][1][m][1] * rstd + cu1;
                const f32x4 v0 = fsilu4(ga) * ua, v1 = fsilu4(gb) * ub;
                u32x4 w; w.x = cvt_pk_bf16(v0[0], v0[1]); w.y = cvt_pk_bf16(v0[2], v0[3]); w.z = cvt_pk_bf16(v1[0], v1[1]); w.w = cvt_pk_bf16(v1[2], v1[3]);
                *(u32x4*)rowp = w; }
    }
};

template <class Epi, class Sched, bool ALIGN_EPI = false, bool SP2 = false>
__device__ __forceinline__ void gemm_phase(PG8_LAS unsigned char* lds, const Gemm g, const Sched& S, const Epi& E) {
    int tid_ = threadIdx.x; asm volatile("" : "+v"(tid_));
    const int tid = tid_, wid = __builtin_amdgcn_readfirstlane(tid >> 6), lane = tid & 63, wr = wid >> 2, wc = wid & 3, fr = lane & 15, fq = lane >> 4;
    const int K = g.K, nt = K / BK;
    unsigned voffA[2], voffB[2];
#pragma unroll
    for (int i = 0; i < 2; ++i) { int R, C; stage_rc(tid * 16 + i * 8192, R, C); const int Rb = Epi::PERM ? ((R & ~31) + perm32(R & 31)) : R;
        voffA[i] = (unsigned)(R * K + C) * 2u; voffB[i] = (unsigned)(Rb * K + C) * 2u; }
    const size_t kstep = (size_t)(BK * 2);
    const size_t hstep = (size_t)HALF * K * 2;
    const size_t tstep = 2 * hstep;
    const unsigned ldsw = (unsigned)wid * 1024u;
    const int aoff = lds_byte(wr * 64 + fr, fq * 8), boff = lds_byte(wc * 32 + fr, fq * 8);
#define PG8_SA(b, h) (((b) * 2 + (h)) * HTB)
#define PG8_SB(b, h) ((4 + (b) * 2 + (h)) * HTB)
#define PG8_STAGE(bufoff, gbase, voff) do { const char* gb_ = (const char*)(gbase); asm volatile("" : "+s"(gb_)); _Pragma("unroll") for (int _i = 0; _i < 2; ++_i) { unsigned vo_ = (voff)[_i]; asm volatile("" : "+v"(vo_));        \
        __builtin_amdgcn_global_load_lds((const unsigned*)(gb_ + vo_), (PG8_LAS unsigned*)(lds + (bufoff) + ldsw + _i * 8192), 16, 0, 0); } } while (0)
#define PG8_LDA(dst, b, h) do { _Pragma("unroll") for (int m = 0; m < 4; ++m) _Pragma("unroll") for (int k = 0; k < 2; ++k) dst[m][k] = *(const PG8_LAS bf16x8*)(lds + PG8_SA(b, h) + aoff + m * 2048 + k * 1024); } while (0)
#define PG8_LDB(dst, b, h) do { _Pragma("unroll") for (int n = 0; n < 2; ++n) _Pragma("unroll") for (int k = 0; k < 2; ++k) dst[n][k] = *(const PG8_LAS bf16x8*)(lds + PG8_SB(b, h) + boff + n * 2048 + k * 1024); } while (0)
#define PG8_MMA(ai, bj, At, Bt) do { __builtin_amdgcn_s_setprio(1); _Pragma("unroll") for (int m = 0; m < 4; ++m) _Pragma("unroll") for (int n = 0; n < 2; ++n) _Pragma("unroll") for (int k = 0; k < 2; ++k) \
        acc[ai][bj][m][n] = __builtin_amdgcn_mfma_f32_16x16x32_bf16(Bt[n][k], At[m][k], acc[ai][bj][m][n], 0, 0, 0); __builtin_amdgcn_s_setprio(0); } while (0)
#define PG8_WAIT_V(n) asm volatile("s_waitcnt vmcnt(" #n ")" ::: "memory")
#define PG8_WAIT_L(n) asm volatile("s_waitcnt lgkmcnt(" #n ")" ::: "memory")
#define PG8_BAR __builtin_amdgcn_s_barrier()
#define PG8_SCHED __builtin_amdgcn_sched_barrier(0)
    Unit cur, nxt; int ui = 0;
    if (!S.next(0, cur)) return;
    f32x4 acc[2][2][4][2];
#pragma unroll
    for (int a = 0; a < 2; ++a)
#pragma unroll
        for (int b = 0; b < 2; ++b)
#pragma unroll
            for (int m = 0; m < 4; ++m)
#pragma unroll
                for (int n = 0; n < 2; ++n) acc[a][b][m][n] = (f32x4){0.f, 0.f, 0.f, 0.f};
    bf16x8 At[4][2], B0[2][2], B1[2][2];
    const char* cA = (const char*)g.A + (size_t)cur.pm * tstep; const char* cB = (const char*)g.Bt + (size_t)cur.pn * tstep;
    S.a_ready(cur);
    if constexpr (SP2) {
        PG8_STAGE(PG8_SB(0, 0), cB, voffB); PG8_STAGE(PG8_SB(0, 1), cB + hstep, voffB); PG8_STAGE(PG8_SA(0, 0), cA, voffA); PG8_STAGE(PG8_SA(0, 1), cA + hstep, voffA);
        if (wr == 1) PG8_BAR;
        PG8_WAIT_V(2); PG8_BAR;
        PG8_STAGE(PG8_SB(1, 0), cB + kstep, voffB); PG8_STAGE(PG8_SA(1, 0), cA + kstep, voffA); PG8_STAGE(PG8_SB(1, 1), cB + hstep + kstep, voffB);
        PG8_WAIT_V(6); PG8_BAR;
    } else {
        PG8_STAGE(PG8_SB(0, 0), cB, voffB); PG8_STAGE(PG8_SA(0, 0), cA, voffA); PG8_STAGE(PG8_SB(0, 1), cB + hstep, voffB); PG8_STAGE(PG8_SA(0, 1), cA + hstep, voffA);
        if (wr == 1) PG8_BAR;
        PG8_WAIT_V(4); PG8_BAR;
        PG8_STAGE(PG8_SB(1, 0), cB + kstep, voffB); PG8_STAGE(PG8_SA(1, 0), cA + kstep, voffA); PG8_STAGE(PG8_SB(1, 1), cB + hstep + kstep, voffB);
        PG8_WAIT_V(6); PG8_BAR;
    }
    for (;;) {
        const bool has_next = S.next(ui + 1, nxt);
        const char* nA = has_next ? (const char*)g.A + (size_t)nxt.pm * tstep : cA; const char* nB = has_next ? (const char*)g.Bt + (size_t)nxt.pn * tstep : cB;
        for (int t = 0; t < nt; t += 2) {
            const bool last = (t == nt - 2);
            const char* a1 = cA + (size_t)(t + 1) * kstep;
            const char* a2 = last ? nA : cA + (size_t)(t + 2) * kstep; const char* b2 = last ? nB : cB + (size_t)(t + 2) * kstep;
            const char* a3 = a2 + kstep; const char* b3 = b2 + kstep;
            if (last && has_next) S.a_ready(nxt);
            if constexpr (SP2) {
            PG8_LDB(B0, 0, 0); PG8_LDB(B1, 0, 1); PG8_SCHED; PG8_LDA(At, 0, 0); PG8_STAGE(PG8_SA(1, 1), a1 + hstep, voffA);
            PG8_WAIT_V(8); PG8_WAIT_L(0); PG8_BAR; PG8_MMA(0, 0, At, B0); PG8_MMA(0, 1, At, B1); PG8_BAR; PG8_SCHED;
            PG8_LDA(At, 0, 1); PG8_STAGE(PG8_SB(0, 0), b2, voffB); PG8_STAGE(PG8_SB(0, 1), b2 + hstep, voffB); PG8_STAGE(PG8_SA(0, 0), a2, voffA);
            PG8_WAIT_V(8); PG8_WAIT_L(0); PG8_BAR; PG8_MMA(1, 0, At, B0); PG8_MMA(1, 1, At, B1); PG8_BAR; PG8_SCHED;
            PG8_LDB(B0, 1, 0); PG8_LDB(B1, 1, 1); PG8_SCHED; PG8_LDA(At, 1, 0); PG8_STAGE(PG8_SA(0, 1), a2 + hstep, voffA);
            PG8_WAIT_V(8); PG8_WAIT_L(0); PG8_BAR; PG8_MMA(0, 0, At, B0); PG8_MMA(0, 1, At, B1); PG8_BAR; PG8_SCHED;
            PG8_LDA(At, 1, 1); PG8_STAGE(PG8_SB(1, 0), b3, voffB); PG8_STAGE(PG8_SB(1, 1), b3 + hstep, voffB); PG8_STAGE(PG8_SA(1, 0), a3, voffA);
            PG8_WAIT_V(8); PG8_WAIT_L(0); PG8_BAR; PG8_MMA(1, 0, At, B0); PG8_MMA(1, 1, At, B1); PG8_BAR; PG8_SCHED;
            } else {
            PG8_LDB(B0, 0, 0); PG8_SCHED; PG8_LDA(At, 0, 0); PG8_STAGE(PG8_SA(1, 1), a1 + hstep, voffA);
            PG8_WAIT_L(8); PG8_BAR; PG8_WAIT_L(0); PG8_MMA(0, 0, At, B0); PG8_BAR; PG8_SCHED;
            PG8_LDB(B1, 0, 1); PG8_STAGE(PG8_SB(0, 0), b2, voffB);
            PG8_BAR; PG8_WAIT_L(0); PG8_MMA(0, 1, At, B1); PG8_BAR;
            PG8_LDA(At, 0, 1); PG8_STAGE(PG8_SA(0, 0), a2, voffA);
            PG8_BAR; PG8_WAIT_L(0); PG8_MMA(1, 0, At, B0); PG8_BAR; PG8_SCHED;
            PG8_STAGE(PG8_SB(0, 1), b2 + hstep, voffB);
            PG8_WAIT_V(6); PG8_BAR; PG8_MMA(1, 1, At, B1); PG8_BAR;
            PG8_LDB(B0, 1, 0); PG8_SCHED; PG8_LDA(At, 1, 0); PG8_STAGE(PG8_SA(0, 1), a2 + hstep, voffA);
            PG8_WAIT_L(8); PG8_BAR; PG8_WAIT_L(0); PG8_MMA(0, 0, At, B0); PG8_BAR; PG8_SCHED;
            PG8_LDB(B1, 1, 1); PG8_STAGE(PG8_SB(1, 0), b3, voffB);
            PG8_BAR; PG8_WAIT_L(0); PG8_MMA(0, 1, At, B1); PG8_BAR;
            PG8_LDA(At, 1, 1); PG8_STAGE(PG8_SA(1, 0), a3, voffA);
            PG8_BAR; PG8_WAIT_L(0); PG8_MMA(1, 0, At, B0); PG8_BAR; PG8_SCHED;
            PG8_STAGE(PG8_SB(1, 1), b3 + hstep, voffB);
            PG8_WAIT_V(6); PG8_BAR; PG8_MMA(1, 1, At, B1); PG8_BAR;
            }
        }
        if constexpr (ALIGN_EPI) { if (wr == 0) PG8_BAR; }
        if constexpr (!Epi::AFTER_DRAIN) { E(acc, cur, wr, wc, fr, fq); S.done(cur); }
        if (!has_next) break;
#pragma unroll
        for (int a = 0; a < 2; ++a)
#pragma unroll
            for (int b = 0; b < 2; ++b)
#pragma unroll
                for (int m = 0; m < 4; ++m)
#pragma unroll
                    for (int n = 0; n < 2; ++n) acc[a][b][m][n] = (f32x4){0.f, 0.f, 0.f, 0.f};
        cur = nxt; cA = nA; cB = nB; ++ui;
        if constexpr (ALIGN_EPI) { if (wr == 1) PG8_BAR; }
    }
    PG8_WAIT_V(0);
    if constexpr (!ALIGN_EPI) { if (wr == 0) PG8_BAR; }
    PG8_BAR;
    if constexpr (Epi::AFTER_DRAIN) { E.fused(acc, cur, wr, wc, fr, fq, lds, wid, lane); S.done(cur); }
#undef PG8_SA
#undef PG8_SB
#undef PG8_STAGE
#undef PG8_LDA
#undef PG8_LDB
#undef PG8_MMA
#undef PG8_WAIT_V
#undef PG8_WAIT_L
#undef PG8_BAR
#undef PG8_SCHED
}
}

constexpr int NWAVES = 8;
#ifndef MK_PER_PHASE
#define MK_PER_PHASE 0
#endif
constexpr int BATCH = 2, SEQ = 8192, DM = 2048, DEPTH = 4, M = BATCH * SEQ, INC = 7168, DFF = 5632, NMODC = 6 * DM;
constexpr int HGW = 1024, HD = 128, NH = 8;
constexpr float EPS = 1e-6f;
constexpr int NPL = 7;
constexpr int NPH = 3 + DEPTH * NPL;

constexpr size_t MiB = 1u << 20;
constexpr size_t WS_CTL = 0, CTL_ZERO_BYTES = 3 * MiB;
constexpr size_t WS_SS = 256 * 1024;
constexpr size_t WS_C1 = 256 * 1024 + 1024 * 1024;
constexpr size_t WS_C2 = WS_C1 + (size_t)DEPTH * BATCH * INC * 8;
static_assert(WS_C2 + (size_t)DEPTH * BATCH * 2 * DFF * 8 <= CTL_ZERO_BYTES, "accumulators inside the memset region");
constexpr size_t WS_MOD = 3 * MiB;
constexpr size_t WS_CF = 4 * MiB;
constexpr size_t WS_LB = 3 * MiB + 512 * 1024;
constexpr size_t WS_WT = 5 * MiB, WT_LAYER = 102 * MiB;
constexpr size_t WT_IN = 0, WT_OUT = 28 * MiB, WT_FI = 36 * MiB, WT_FO = 80 * MiB;
constexpr size_t WS_H = WS_WT + DEPTH * WT_LAYER;
constexpr size_t WS_P16 = WS_H + 64 * MiB;
constexpr size_t WS_MIX = WS_P16 + 256 * MiB;
constexpr size_t WS_HID = WS_MIX + 64 * MiB;
constexpr size_t WS_SLOC = WS_HID + 176 * MiB;
constexpr size_t WS_DEC = WS_SLOC + 64 * MiB;
constexpr size_t WS_XA = WS_DEC + 1 * MiB;
constexpr size_t WS_SPREV = WS_XA + 64 * MiB;
constexpr size_t WS_END = WS_SPREV + 64 * MiB;
static_assert((size_t)INC * DM * 2 == 28 * MiB && (size_t)DM * DM * 2 == 8 * MiB && (size_t)2 * DFF * DM * 2 == 44 * MiB && (size_t)DM * DFF * 2 == 22 * MiB, "weight copy sizes");
static_assert((size_t)M * DFF * 2 == 176 * MiB && (size_t)M * 8192 * 2 == 256 * MiB, "activation sizes");
constexpr int CW_TMO = 0, CW_CODE = 1;
constexpr int CW_BAR = 4096;
constexpr int CW_A1 = 8192;

constexpr int RING_OFF = 0, RING_BYTES = 131072;
constexpr int LDSCTL_OFF = RING_BYTES, MISC_OFF = LDSCTL_OFF + 320;
constexpr int LDS_BYTES = 147456;
static_assert(MISC_OFF + 128 <= LDS_BYTES, "LDS map");

#define GAS __attribute__((address_space(1)))
#define LAS __attribute__((address_space(3)))
typedef unsigned short bf16;
typedef unsigned v4u __attribute__((ext_vector_type(4)));
typedef unsigned v2u __attribute__((ext_vector_type(2)));
typedef float f32x4 __attribute__((ext_vector_type(4)));
typedef float f32x2 __attribute__((ext_vector_type(2)));
typedef GAS unsigned gu32;
typedef GAS unsigned long long gu64;
#define RLX_AGENT __ATOMIC_RELAXED, __HIP_MEMORY_SCOPE_AGENT
#define LDS_WAIT() asm volatile("s_waitcnt lgkmcnt(0)" ::: "memory")
#define VM_WAIT() asm volatile("s_waitcnt vmcnt(0)" ::: "memory")
__device__ __forceinline__ unsigned f2bf(float f) { unsigned u = __builtin_bit_cast(unsigned, f); return (u + 0x7fffu + ((u >> 16) & 1u)) >> 16; }
typedef float f32x2_t_ __attribute__((ext_vector_type(2))); typedef __bf16 bf16x2_t_ __attribute__((ext_vector_type(2)));
__device__ __forceinline__ unsigned pk2(float lo, float hi) { const f32x2_t_ v = {lo, hi}; const bf16x2_t_ b = __builtin_convertvector(v, bf16x2_t_); return __builtin_bit_cast(unsigned, b); }
__device__ __forceinline__ float bflo(unsigned w) { return __builtin_bit_cast(float, w << 16); }
__device__ __forceinline__ float bfhi(unsigned w) { return __builtin_bit_cast(float, w & 0xffff0000u); }
__device__ __forceinline__ float h2f(unsigned short hbits) { return (float)__builtin_bit_cast(_Float16, hbits); }

#define XB_TMO      128
#define XB_XCNT(j)  (256  + 64 * (j))
#define XB_XSUB(j)  (1280 + 64 * (j))
#define XB_XGEN(j)  (2304 + 64 * (j))
#define XB_TOP      3328
#define XB_TOPGEN   3392
#define XCD_BAR_WORDS 3456
#define XB_SPIN_CAP (1u << 18)

__device__ __forceinline__ unsigned xb_ld(unsigned* p)              { return __hip_atomic_load(p, __ATOMIC_RELAXED, __HIP_MEMORY_SCOPE_AGENT); }
__device__ __forceinline__ unsigned xb_add(unsigned* p, unsigned v) { return __hip_atomic_fetch_add(p, v, __ATOMIC_RELAXED, __HIP_MEMORY_SCOPE_AGENT); }
__device__ __forceinline__ unsigned xb_xcc_id() { return (unsigned)__builtin_amdgcn_s_getreg((3 << 11) | 20) & 0xFu; }
#define XB_SPIN(cond, bar) do { unsigned _sp = 0; while (cond) { __builtin_amdgcn_s_sleep(1); \
    if ((++_sp & 255u) == 0u) { if (xb_ld(&(bar)[XB_TMO])) break; if (_sp > XB_SPIN_CAP) { atomicAdd(&(bar)[XB_TMO], 1u); break; } } } } while (0)

struct XcdBarrier {
    unsigned* bar; unsigned x;
    volatile LAS unsigned* st;
};

__device__ __forceinline__ XcdBarrier xcd_barrier_post(unsigned* bar, volatile LAS unsigned* st) {
    XcdBarrier b; b.bar = bar; b.x = xb_xcc_id(); b.st = st;
    if (threadIdx.x == 0) (void)xb_add(&bar[XB_XCNT(b.x)], 1u);
    return b;
}
__device__ __forceinline__ void xcd_barrier_complete(unsigned* bar, unsigned x, unsigned& nloc, unsigned& nx) {
    const unsigned G = gridDim.x * gridDim.y * gridDim.z;
    unsigned sum, cnt, mine, sp = 0u;
    for (;;) {
        sum = 0u; cnt = 0u; mine = 0u;
#pragma unroll
        for (unsigned j = 0; j < 16; ++j) { const unsigned c = xb_ld(&bar[XB_XCNT(j)]); sum += c; cnt += (c > 0u) ? 1u : 0u; mine = (j == x) ? c : mine; }
        if (sum == G) break;
        __builtin_amdgcn_s_sleep(1);
        if ((++sp & 255u) == 0u) { if (xb_ld(&bar[XB_TMO])) break; if (sp > XB_SPIN_CAP) { atomicAdd(&bar[XB_TMO], 1u); break; } }
    }
    nloc = mine > 0u ? mine : 1u; nx = cnt > 0u ? cnt : 1u;
}

__device__ __forceinline__ void xcd_barrier(const XcdBarrier& b) {
    asm volatile("s_waitcnt vmcnt(0)" ::: "memory");
    __syncthreads();
    if (threadIdx.x == 0) {
        unsigned* bar = b.bar;
        __builtin_amdgcn_s_waitcnt(0);
        unsigned nloc = b.st[0], nx = b.st[1];
        if (nloc == 0u) { xcd_barrier_complete(bar, b.x, nloc, nx); b.st[0] = nloc; b.st[1] = nx; }
        const unsigned old = xb_add(&bar[XB_XSUB(b.x)], 1u);
        const unsigned gen = old / nloc;
        if (old + 1u == (gen + 1u) * nloc) {
            __builtin_amdgcn_fence(__ATOMIC_RELEASE, "agent");
            asm volatile("s_waitcnt vmcnt(0)" ::: "memory");
            const unsigned og = xb_add(&bar[XB_TOP], 1u);
            const unsigned tg = og / nx;
            if (og + 1u == (tg + 1u) * nx) xb_add(&bar[XB_TOPGEN], 1u);
            else XB_SPIN(xb_ld(&bar[XB_TOPGEN]) == tg, bar);
            __builtin_amdgcn_fence(__ATOMIC_ACQUIRE, "agent");
            xb_add(&bar[XB_XGEN(b.x)], 1u);
            asm volatile("s_waitcnt vmcnt(0)" ::: "memory");
        } else {
            XB_SPIN(xb_ld(&bar[XB_XGEN(b.x)]) == gen, bar);
            __builtin_amdgcn_fence(__ATOMIC_ACQUIRE, "agent");
            asm volatile("s_waitcnt vmcnt(0)" ::: "memory");
        }
    }
    __syncthreads();
}

struct Args { const float* in[15]; float* out; unsigned char* ws; int ph_lo, ph_hi, li, pad; };
struct Frame {
    LAS unsigned char* lds;
    volatile LAS unsigned* MISC;
    gu32* ctl;
    int tid, lane, wave;
    int vcu, G;
    float* out;
    unsigned char* ws;
};
#define F_x (args.in[0])
#define F_c (args.in[1])
#define F_norm1_g (args.in[2])
#define F_w_in (args.in[3])
#define F_hg_lb_logits (args.in[4])
#define F_hg_out_g (args.in[5])
#define F_sb_q_g (args.in[6])
#define F_sb_k_g (args.in[7])
#define F_sb_out_g (args.in[8])
#define F_w_out (args.in[9])
#define F_norm2_g (args.in[10])
#define F_w_ffn_in (args.in[11])
#define F_w_ffn_out (args.in[12])
#define F_w_ada (args.in[13])
#define F_b_ada (args.in[14])
#define F_MOD ((float*)(F.ws + WS_MOD))
#define F_LB ((float*)(F.ws + WS_LB))
#define F_H ((bf16*)(F.ws + WS_H))
#define F_P16 ((bf16*)(F.ws + WS_P16))
#define F_MIX ((bf16*)(F.ws + WS_MIX))
#define F_HID ((bf16*)(F.ws + WS_HID))
template <int CTRL> __device__ __forceinline__ float dpp_f(float v) { return __builtin_bit_cast(float, __builtin_amdgcn_update_dpp(0, __builtin_bit_cast(int, v), CTRL, 0xf, 0xf, false)); }
__device__ __forceinline__ float quad_sum(float v) { v += dpp_f<0xB1>(v); v += dpp_f<0x4E>(v); return v; }
__device__ __forceinline__ float row16_sum(float v) { v = quad_sum(v); v += dpp_f<0x141>(v); v += dpp_f<0x140>(v); return v; }
__device__ __forceinline__ float wave_sum(float v) {
    v = row16_sum(v);
    const int vi = __builtin_bit_cast(int, v);
    const float r0 = __builtin_bit_cast(float, __builtin_amdgcn_readlane(vi, 0)), r1 = __builtin_bit_cast(float, __builtin_amdgcn_readlane(vi, 16)), r2 = __builtin_bit_cast(float, __builtin_amdgcn_readlane(vi, 32)), r3 = __builtin_bit_cast(float, __builtin_amdgcn_readlane(vi, 48));
    return (r0 + r1) + (r2 + r3);
}

#define PHASE_FRAME(Fl) Frame Fl = F; { int t_ = F.tid; asm volatile("" : "+v"(t_)); Fl.tid = t_; Fl.lane = t_ & 63; Fl.wave = __builtin_amdgcn_readfirstlane(t_ >> 6); int v_ = F.vcu; asm volatile("" : "+s"(v_)); Fl.vcu = v_; }
__device__ __forceinline__ void transpose_item(const float* W, int K, int N, bf16* WT, int k0, int n_src0, int n_dst0, LAS float* scr, int lane, const float* sh, int sh_bstride, long long* cdst, int cstride) {
    LAS float* shl = scr + 64 * 33;
    if (sh) { shl[lane] = sh[k0 + lane]; shl[64 + lane] = sh[sh_bstride + k0 + lane]; }
#pragma unroll 8
    for (int i = 0; i < 32; ++i) { const int kk = 2 * i + (lane >> 5); scr[kk * 33 + (lane & 31)] = W[(size_t)(k0 + kk) * N + n_src0 + (lane & 31)]; }
    LDS_WAIT(); asm volatile("" ::: "memory");
    const int c = lane & 7;
#pragma unroll
    for (int j = 0; j < 4; ++j) { const int n = (lane >> 3) + 8 * j; const LAS float* s = scr + (8 * c) * 33 + n;
        v4u o; o.x = pk2(s[0 * 33], s[1 * 33]); o.y = pk2(s[2 * 33], s[3 * 33]); o.z = pk2(s[4 * 33], s[5 * 33]); o.w = pk2(s[6 * 33], s[7 * 33]);
        *(GAS v4u*)(WT + (size_t)(n_dst0 + n) * K + k0 + 8 * c) = o; }
    if (sh) { const int n = lane & 31, hf = lane >> 5; float s0 = 0.f, s1 = 0.f;
#pragma unroll 8
        for (int i = 0; i < 32; ++i) { const int kk = 32 * hf + i; const float w = scr[kk * 33 + n]; s0 += shl[kk] * w; s1 += shl[64 + kk] * w; }
        s0 += __shfl_xor(s0, 32); s1 += __shfl_xor(s1, 32);
        if (hf == 0) { pg8::fx_add(cdst + n_dst0 + n, s0, pg8::C_SCALE); pg8::fx_add(cdst + cstride + n_dst0 + n, s1, pg8::C_SCALE); } }
    LDS_WAIT(); asm volatile("" ::: "memory");
}
__device__ __forceinline__ void mod_unit(Frame& F, const Args& args, int unit) {
    const int l = unit / 48, cb = unit % 48;
    LAS float* cond = (LAS float*)(F.lds);
    LAS float* part = (LAS float*)(F.lds + 16384);
    for (int i = F.tid; i < 2 * DM; i += NWAVES * 64) { const float v = F_c[i]; cond[i] = v / (1.0f + __expf(-v)); }
    __syncthreads();
    const float* W = F_w_ada + (size_t)l * DM * NMODC + cb * 256 + F.lane * 4;
    f32x4 a0 = {0.f, 0.f, 0.f, 0.f}, a1 = {0.f, 0.f, 0.f, 0.f};
    const int kb = F.wave * 256;
#pragma unroll 32
    for (int k = 0; k < 256; ++k) { const f32x4 w = *(const GAS f32x4*)(W + (size_t)(kb + k) * NMODC); a0 += cond[kb + k] * w; a1 += cond[DM + kb + k] * w; }
    *(LAS f32x4*)(part + (F.wave * 2 + 0) * 256 + F.lane * 4) = a0;
    *(LAS f32x4*)(part + (F.wave * 2 + 1) * 256 + F.lane * 4) = a1;
    __syncthreads();
    { const int b = F.tid >> 8, col = F.tid & 255; float s = F_b_ada[l * NMODC + cb * 256 + col];
#pragma unroll
      for (int w = 0; w < 8; ++w) s += part[(w * 2 + b) * 256 + col];
      F_MOD[(size_t)(l * 2 + b) * NMODC + cb * 256 + col] = s; }
    __syncthreads();
}
__device__ __forceinline__ void lb_table(Frame& F, const Args& args) {
    for (int d = F.tid; d < HGW; d += NWAVES * 64) {
        const float x0 = F_hg_lb_logits[d], x1 = F_hg_lb_logits[HGW + d], x2 = F_hg_lb_logits[2 * HGW + d], x3 = F_hg_lb_logits[3 * HGW + d];
        const float mx = fmaxf(fmaxf(x0, x1), fmaxf(x2, x3));
        const float e0 = expf(x0 - mx), e1 = expf(x1 - mx), e2 = expf(x2 - mx), e3 = expf(x3 - mx), inv = 1.0f / (e0 + e1 + e2 + e3);
        const float p1 = e1 * inv, p2 = e2 * inv, p3 = e3 * inv;
        F_LB[d] = 0.f; F_LB[HGW + d] = p1; F_LB[2 * HGW + d] = p1 + p2; F_LB[3 * HGW + d] = (p1 + p2) + p3;
    }
}
__device__ __forceinline__ void p0_prologue_a(Frame& F, const Args& args) {
    if (F.vcu < DEPTH * 16) { const int l = F.vcu >> 4, j = F.vcu & 15; mod_unit(F, args, l * 48 + ((j < 8) ? j : 24 + (j - 8))); }
    if (F.vcu == F.G - 1) lb_table(F, args);
    __syncthreads();
    LAS float* scr = (LAS float*)(F.lds + RING_OFF + F.wave * 16384);
    const int gw = F.vcu * NWAVES + F.wave, NGW = F.G * NWAVES;
    constexpr int I_OUT = (DM / 64) * (DM / 32), I_FO = (DFF / 64) * (DM / 32), I_LAYER = I_OUT + I_FO;
    for (int it = gw; it < DEPTH * I_LAYER; it += NGW) {
        const int l = it / I_LAYER; int r = it % I_LAYER;
        unsigned char* wt = F.ws + WS_WT + (size_t)l * WT_LAYER;
        if (r < I_OUT) { const int nblk = DM / 32, kb = r / nblk, nb = r % nblk;
            transpose_item(F_w_out + (size_t)l * DM * DM, DM, DM, (bf16*)(wt + WT_OUT), 64 * kb, 32 * nb, 32 * nb, scr, F.lane, nullptr, 0, nullptr, 0); continue; } r -= I_OUT;
        { const int nblk = DM / 32, kb = r / nblk, nb = r % nblk;
            transpose_item(F_w_ffn_out + (size_t)l * DFF * DM, DFF, DM, (bf16*)(wt + WT_FO), 64 * kb, 32 * nb, 32 * nb, scr, F.lane, nullptr, 0, nullptr, 0); }
    }
}
__device__ __forceinline__ void p0_prologue_b(Frame& F, const Args& args) {
    if (F.vcu < DEPTH * 32) { const int l = F.vcu >> 5, j = F.vcu & 31; mod_unit(F, args, l * 48 + ((j < 16) ? 8 + j : 32 + (j - 16))); }
    __syncthreads();
    LAS float* scr = (LAS float*)(F.lds + RING_OFF + F.wave * 16384);
    const int gw = F.vcu * NWAVES + F.wave, NGW = F.G * NWAVES;
    constexpr int I_IN = (DM / 64) * (INC / 32), I_FI = (DM / 64) * (2 * DFF / 32), I_LAYER = I_IN + I_FI;
    for (int it = gw; it < DEPTH * I_LAYER; it += NGW) {
        const int l = it / I_LAYER; int r = it % I_LAYER;
        unsigned char* wt = F.ws + WS_WT + (size_t)l * WT_LAYER;
        const float* modl = F_MOD + (size_t)l * 2 * NMODC;
        if (r < I_IN) { const int nblk = INC / 32, kb = r / nblk, nb = r % nblk;
            transpose_item(F_w_in + (size_t)l * DM * INC, DM, INC, (bf16*)(wt + WT_IN), 64 * kb, 32 * nb, 32 * nb, scr, F.lane, modl, NMODC, (long long*)(F.ws + WS_C1) + (size_t)l * BATCH * INC, INC); continue; } r -= I_IN;
        { const int nblk = 2 * DFF / 32, kb = r / nblk, nb = r % nblk, p = nb >> 3, q = nb & 7;
            const int nsrc = (q < 4) ? (128 * p + 32 * q) : (DFF + 128 * p + 32 * (q - 4));
            transpose_item(F_w_ffn_in + (size_t)l * DM * 2 * DFF, DM, 2 * DFF, (bf16*)(wt + WT_FI), 64 * kb, nsrc, 32 * nb, scr, F.lane, modl + 3 * DM, NMODC, (long long*)(F.ws + WS_C2) + (size_t)l * BATCH * 2 * DFF, 2 * DFF); }
    }
}
__device__ __forceinline__ void norm0_phase(Frame& F, const float* x, const float* g, const float* modl, int sc_off, long long* ss) {
    const int gw = F.vcu * NWAVES + F.wave, NGW = F.G * NWAVES;
    for (int row = gw; row < M; row += NGW) {
        const float* mb = modl + (size_t)(row / SEQ) * NMODC;
        const GAS f32x4* xr = (const GAS f32x4*)(x + (size_t)row * DM) + F.lane;
        f32x4 v[8]; float s = 0.f;
#pragma unroll
        for (int j = 0; j < 8; ++j) { v[j] = xr[64 * j]; s += (v[j].x * v[j].x + v[j].y * v[j].y) + (v[j].z * v[j].z + v[j].w * v[j].w); }
        s = wave_sum(s);
        if (F.lane == 0) ss[row] = __float2ll_rn(s * pg8::SS_SCALE);
        GAS v2u* o8 = (GAS v2u*)(F_H + (size_t)row * DM) + F.lane;
#pragma unroll
        for (int j = 0; j < 8; ++j) { const int col = 4 * F.lane + 256 * j;
            const f32x4 gg = *(const GAS f32x4*)(g + col), sc = *(const GAS f32x4*)(mb + sc_off + col);
            const f32x4 y = v[j] * gg * (1.0f + sc);
            v2u w; w.x = pk2(y.x, y.y); w.y = pk2(y.z, y.w); o8[64 * j] = w; }
    }
}

typedef short bf16x8 __attribute__((ext_vector_type(8)));
constexpr int P16S = pg8::P16_LD;
constexpr int TS = 136;
constexpr int VS = 72;
constexpr int VR = 144;
constexpr int HG_UNITS = BATCH * NH * (SEQ / 64);
typedef short s16x4 __attribute__((ext_vector_type(4)));
__device__ __forceinline__ bf16x8 tr_frag(const LAS unsigned short* p0, const LAS unsigned short* p1) {
    const s16x4 a = __builtin_bit_cast(s16x4, __builtin_amdgcn_ds_read_tr16_b64_v4i16((LAS s16x4*)p0)), b = __builtin_bit_cast(s16x4, __builtin_amdgcn_ds_read_tr16_b64_v4i16((LAS s16x4*)p1));
    return (bf16x8){a[0], a[1], a[2], a[3], b[0], b[1], b[2], b[3]};
}
#define LDS_BARRIER() do { asm volatile("s_waitcnt lgkmcnt(0)" ::: "memory"); __builtin_amdgcn_s_barrier(); asm volatile("" ::: "memory"); } while (0)
#define MFMA16(X, Y, C) __builtin_amdgcn_mfma_f32_16x16x32_bf16((X), (Y), (C), 0, 0, 0)
__device__ __forceinline__ f32x2 expv(f32x2 v) { const f32x2 t = v * 1.4426950408889634f; return (f32x2){__builtin_amdgcn_exp2f(t.x), __builtin_amdgcn_exp2f(t.y)}; }
__device__ __forceinline__ f32x2 minv(f32x2 v, float m) { return (f32x2){fminf(v.x, m), fminf(v.y, m)}; }
__device__ __forceinline__ f32x2 h2v(unsigned w) { return (f32x2){h2f((unsigned short)(w & 0xffffu)), h2f((unsigned short)(w >> 16))}; }
__device__ __forceinline__ unsigned pk2v(f32x2 v) { return pk2(v.x, v.y); }


struct HgRegs { unsigned lf[8], q[8]; v4u v[2]; };
template <bool WANT_Q> __device__ __forceinline__ void hg_issue(Frame& F, HgRegs& R, int u) {
    const int bh = u >> 7, c = u & 127, b = bh >> 3, h = bh & 7, dp = F.tid & 63, grp = F.tid >> 6;
    const bf16* P = F_P16 + (size_t)(b * SEQ + 64 * c) * P16S + h * HD;
#pragma unroll
    for (int j = 0; j < 8; ++j) { const bf16* src = P + (size_t)(8 * grp + j) * P16S + 2 * dp;
        R.lf[j] = *(const GAS unsigned*)(src + 1024); if (WANT_Q) R.q[j] = *(const GAS unsigned*)(src); }
#pragma unroll
    for (int i = 0; i < 2; ++i) { const int ch = F.tid + 512 * i, r = ch >> 4, cc = ch & 15; R.v[i] = *(const GAS v4u*)(P + (size_t)r * P16S + 2048 + cc * 8); }
}
__device__ __forceinline__ void hgrn2_a1_all(Frame& F) {
    constexpr int SET = 64 * VR * 2 + 8 * 128 * 2;
    const int dp = F.tid & 63, grp = F.tid >> 6, g = F.lane >> 4, li = F.lane & 15;
    HgRegs R; int u = F.vcu, par = 0;
    if (u < HG_UNITS) hg_issue<false>(F, R, u);
    while (u < HG_UNITS) {
        LAS unsigned short* Lk = (LAS unsigned short*)(F.lds) + par * SET;
        LAS unsigned short* Lv = Lk + 64 * VR;
        LAS float* Ltot = (LAS float*)(Lv + 64 * VR);
        f32x2 bl[8]; { f32x2 r = {0.f, 0.f};
#pragma unroll
            for (int j = 0; j < 8; ++j) { r += h2v(R.lf[j]); bl[j] = r; }
            *(LAS f32x2*)(Ltot + grp * 128 + 2 * dp) = r; }
#pragma unroll
        for (int i = 0; i < 2; ++i) { const int ch = F.tid + 512 * i, r = ch >> 4, cc = ch & 15; *(LAS v4u*)(Lv + r * VR + cc * 8) = R.v[i]; }
        LDS_BARRIER();
        { f32x2 off = {0.f, 0.f}, tot = {0.f, 0.f};
#pragma unroll
          for (int gg = 0; gg < 8; ++gg) { const f32x2 t = *(const LAS f32x2*)(Ltot + gg * 128 + 2 * dp); if (gg < grp) off += t; tot += t; }
#pragma unroll
          for (int j = 0; j < 8; ++j) { const f32x2 key = 1.0f - expv(h2v(R.lf[j]));
              *(LAS unsigned*)(Lk + (8 * grp + j) * VR + 2 * dp) = pk2v(key * expv(tot - (bl[j] + off))); }
          if (grp == 0) *(GAS f32x2*)((float*)(F.ws + WS_DEC) + (size_t)u * 128 + 2 * dp) = expv(tot); }
        LDS_BARRIER();
        const int un = u + F.G;
        if (un < HG_UNITS) hg_issue<false>(F, R, un);
        { const LAS unsigned short* xb = Lk + (4 * g + (li >> 2)) * VR + 16 * F.wave + 4 * (li & 3);
          const LAS unsigned short* yb = Lv + (4 * g + (li >> 2)) * VR + 4 * (li & 3);
          const bf16x8 X0 = tr_frag(xb, xb + 16 * VR), X1 = tr_frag(xb + 32 * VR, xb + 48 * VR);
          bf16* so = (bf16*)(F.ws + WS_SLOC) + (size_t)u * 16384 + 16 * F.wave + 4 * g;
#pragma unroll
          for (int eb = 0; eb < 8; ++eb) { const bf16x8 Y0 = tr_frag(yb + 16 * eb, yb + 16 * eb + 16 * VR), Y1 = tr_frag(yb + 16 * eb + 32 * VR, yb + 16 * eb + 48 * VR);
              f32x4 acc = {0.f, 0.f, 0.f, 0.f}; acc = MFMA16(X0, Y0, acc); acc = MFMA16(X1, Y1, acc);
              v2u w; w.x = pk2(acc[0], acc[1]); w.y = pk2(acc[2], acc[3]);
              *(GAS v2u*)(so + (size_t)(16 * eb + li) * 128) = w; } }
        u = un; par ^= 1;
    }
    LDS_BARRIER();
}
__device__ __forceinline__ void hgrn2_a2(Frame& F) {
    const int NGW = F.G * NWAVES;
    for (int row = F.vcu * NWAVES + F.wave; row < BATCH * NH * 128; row += NGW) {
        const int bh = row >> 7, e = row & 127;
        const GAS unsigned* base = (const GAS unsigned*)(F.ws + WS_SLOC) + ((size_t)bh * 128 * 128 + e) * 64 + F.lane;
        GAS unsigned* obase = (GAS unsigned*)(F.ws + WS_SPREV) + ((size_t)bh * 128 * 128 + e) * 64 + F.lane;
        const GAS f32x2* dbase = (const GAS f32x2*)(F.ws + WS_DEC) + (size_t)bh * 128 * 64 + F.lane;
        float S0 = 0.f, S1 = 0.f;
        for (int c0 = 0; c0 < 128; c0 += 32) {
            unsigned loc[32]; f32x2 dc[32];
#pragma unroll
            for (int j = 0; j < 32; ++j) { loc[j] = __builtin_nontemporal_load(base + (size_t)(c0 + j) * 8192); dc[j] = dbase[(c0 + j) * 64]; }
#pragma unroll
            for (int j = 0; j < 32; ++j) { obase[(size_t)(c0 + j) * 8192] = pk2(S0, S1); S0 = dc[j].x * S0 + bflo(loc[j]); S1 = dc[j].y * S1 + bfhi(loc[j]); }
        }
    }
}

__device__ __forceinline__ void hgrn2_a3_all(Frame& F, const Args& args, int layer) {
    LAS unsigned short* Lq = (LAS unsigned short*)(F.lds);
    LAS unsigned short* Lk = Lq + 64 * TS;
    LAS unsigned short* Li = Lk + 64 * TS;
    LAS unsigned short* Lv = Li + 64 * TS;
    LAS unsigned short* LP = Lv + 64 * VR;
    LAS float* Lo = (LAS float*)(LP + 64 * VS);
    LAS float* Ltot = Lo + 64 * 132;
    const int dp = F.tid & 63, grp = F.tid >> 6, g = F.lane >> 4, li = F.lane & 15;
    HgRegs R; bf16x8 Spn[4]; unsigned gate[8]; f32x2 ogn; int u = F.vcu;
#define A3_ISSUE(uu) do { hg_issue<true>(F, R, (uu)); const int bh_ = (uu) >> 7, c_ = (uu) & 127; \
        const bf16* sp_ = (const bf16*)(F.ws + WS_SPREV) + (size_t)(uu) * 16384 + (size_t)(16 * F.wave + li) * 128 + 8 * g; \
        _Pragma("unroll") for (int kd = 0; kd < 4; ++kd) Spn[kd] = *(const GAS bf16x8*)(sp_ + 32 * kd); \
        const bf16* gp_ = F_P16 + (size_t)((bh_ >> 3) * SEQ + 64 * c_ + 8 * F.wave) * P16S + 3072 + (bh_ & 7) * HD + 2 * F.lane; \
        _Pragma("unroll") for (int rr = 0; rr < 8; ++rr) gate[rr] = *(const GAS unsigned*)(gp_ + (size_t)rr * P16S); \
        ogn = *(const GAS f32x2*)(F_hg_out_g + layer * HGW + (bh_ & 7) * HD + 2 * F.lane); } while (0)
    if (u < HG_UNITS) A3_ISSUE(u);
    while (u < HG_UNITS) {
        const int bh = u >> 7, c = u & 127, b = bh >> 3, h = bh & 7;
        const size_t row0 = (size_t)(b * SEQ + 64 * c);
        f32x2 bl[8]; { f32x2 r = {0.f, 0.f};
#pragma unroll
            for (int j = 0; j < 8; ++j) { r += h2v(R.lf[j]); bl[j] = r; }
            *(LAS f32x2*)(Ltot + grp * 128 + 2 * dp) = r; }
#pragma unroll
        for (int i = 0; i < 2; ++i) { const int ch = F.tid + 512 * i, r = ch >> 4, cc = ch & 15; *(LAS v4u*)(Lv + r * VR + cc * 8) = R.v[i]; }
        LDS_BARRIER();
        { f32x2 off = {0.f, 0.f}, ref = {0.f, 0.f};
#pragma unroll
          for (int gg = 0; gg < 7; ++gg) { const f32x2 t = *(const LAS f32x2*)(Ltot + gg * 128 + 2 * dp); if (gg < grp) off += t; if (gg < 4) ref += t; }
#pragma unroll
          for (int j = 0; j < 8; ++j) { const int s = 8 * grp + j; const f32x2 b = bl[j] + off, q = {bflo(R.q[j]), bfhi(R.q[j])};
              *(LAS unsigned*)(Lq + s * TS + 2 * dp) = pk2v(q * expv(minv(b - ref, 80.f)));
              const f32x2 key = 1.0f - expv(h2v(R.lf[j]));
              *(LAS unsigned*)(Lk + s * TS + 2 * dp) = pk2v(key * expv(minv(ref - b, 80.f)));
              *(LAS unsigned*)(Li + s * TS + 2 * dp) = pk2v(q * expv(b)); } }
        bf16x8 Sp[4]; unsigned gw[8];
#pragma unroll
        for (int kd = 0; kd < 4; ++kd) Sp[kd] = Spn[kd];
#pragma unroll
        for (int rr = 0; rr < 8; ++rr) gw[rr] = gate[rr];
        const f32x2 og = ogn;
        LDS_BARRIER();
        const int un = u + F.G;
        if (un < HG_UNITS) A3_ISSUE(un);
#pragma unroll
        for (int k2 = 0; k2 < 2; ++k2) { const int id = 2 * F.wave + k2, si = id >> 2, ti = id & 3;
            f32x4 acc = {0.f, 0.f, 0.f, 0.f};
            if (si <= ti) {
#pragma unroll
                for (int kd = 0; kd < 4; ++kd) { const bf16x8 X = *(const LAS bf16x8*)(Lk + (16 * si + li) * TS + 32 * kd + 8 * g), Y = *(const LAS bf16x8*)(Lq + (16 * ti + li) * TS + 32 * kd + 8 * g);
                    acc = MFMA16(X, Y, acc); }
                const int t = 16 * ti + li, s0 = 16 * si + 4 * g;
#pragma unroll
                for (int r = 0; r < 4; ++r) acc[r] = (s0 + r <= t) ? acc[r] : 0.f; }
            v2u w; w.x = pk2(acc[0], acc[1]); w.y = pk2(acc[2], acc[3]);
            *(LAS v2u*)(LP + (16 * ti + li) * VS + 16 * si + 4 * g) = w; }
        LDS_BARRIER();
        { f32x4 acc[4];
#pragma unroll
          for (int ti = 0; ti < 4; ++ti) acc[ti] = (f32x4){0.f, 0.f, 0.f, 0.f};
          const LAS unsigned short* yb = Lv + (4 * g + (li >> 2)) * VR + 16 * F.wave + 4 * (li & 3);
#pragma unroll
          for (int ks = 0; ks < 2; ++ks) { const bf16x8 Y = tr_frag(yb + 32 * ks * VR, yb + (32 * ks + 16) * VR);
#pragma unroll
              for (int ti = 0; ti < 4; ++ti) { const LAS unsigned short* pp = LP + (16 * ti + li) * VS + 32 * ks + 4 * g; const v2u x0 = *(const LAS v2u*)(pp), x1 = *(const LAS v2u*)(pp + 16);
                  acc[ti] = MFMA16(__builtin_bit_cast(bf16x8, (v4u){x0.x, x0.y, x1.x, x1.y}), Y, acc[ti]); } }
#pragma unroll
          for (int kd = 0; kd < 4; ++kd) {
#pragma unroll
              for (int ti = 0; ti < 4; ++ti) { const bf16x8 X = *(const LAS bf16x8*)(Li + (16 * ti + li) * TS + 32 * kd + 8 * g); acc[ti] = MFMA16(X, Sp[kd], acc[ti]); } }
#pragma unroll
          for (int ti = 0; ti < 4; ++ti)
#pragma unroll
              for (int r = 0; r < 4; ++r) Lo[(16 * ti + 4 * g + r) * 132 + 16 * F.wave + li] = acc[ti][r]; }
        LDS_BARRIER();
        {
#pragma unroll
          for (int rr = 0; rr < 8; ++rr) { const int t = 8 * F.wave + rr; const size_t row = row0 + t;
              const f32x2 o = *(const LAS f32x2*)(Lo + t * 132 + 2 * F.lane);
              const float rstd = __builtin_amdgcn_rsqf(wave_sum(o.x * o.x + o.y * o.y) * (1.0f / HD) + EPS);
              *(GAS unsigned*)(F_MIX + row * DM + h * HD + 2 * F.lane) = pk2(o.x * rstd * og.x * bflo(gw[rr]), o.y * rstd * og.y * bfhi(gw[rr])); } }
        u = un;
    }
    LDS_BARRIER();
#undef A3_ISSUE
}

constexpr int AT_UNITS = BATCH * NH * (SEQ / 128);
constexpr float AT_STOP = 7.888609052210118e-31f;
struct AtRegs { v4u k[4], v[4]; };
__device__ __forceinline__ void at_issue(AtRegs& R, const bf16* Pb, int kb, int lr, int lc) {
#pragma unroll
    for (int i = 0; i < 4; ++i) { const bf16* src = Pb + (size_t)(128 * kb + lr + 32 * i) * P16S + lc * 8; R.k[i] = *(const GAS v4u*)(src + 5120); R.v[i] = *(const GAS v4u*)(src + 6144); }
}
__device__ __forceinline__ void at_half(Frame& F, int kb64, int hb, int tw, const LAS unsigned short* LKh, const LAS unsigned short* LVh, const bf16x8 (&Qf)[4], f32x4 (&O)[8], float& run) {
    const int g = F.lane >> 4, li = F.lane & 15, t = tw + li; const int kb = kb64; const LAS unsigned short* LK = LKh; const LAS unsigned short* LV = LVh;
    {
        float kp[4][4], sg[4][4];
#pragma unroll
        for (int sb = 0; sb < 4; ++sb) { f32x4 acc = {0.f, 0.f, 0.f, 0.f};
#pragma unroll
            for (int kd = 0; kd < 4; ++kd) { const bf16x8 X = *(const LAS bf16x8*)(LK + (16 * sb + li) * TS + 32 * kd + 8 * g); acc = MFMA16(X, Qf[kd], acc); }
#pragma unroll
            for (int r = 0; r < 4; ++r) { const float w = __builtin_amdgcn_exp2f(acc[r]); const float keep = __builtin_amdgcn_rcpf(1.0f + w);
                const bool valid = (64 * kb + 16 * sb + 4 * g + r) < t;
                kp[sb][r] = valid ? keep : 1.0f; sg[sb][r] = 1.0f - kp[sb][r]; } }
        float excl[4], TT[4], e1[4], e0[4];
#pragma unroll
        for (int sb = 0; sb < 4; ++sb) { e1[sb] = kp[sb][3] * kp[sb][2]; e0[sb] = e1[sb] * kp[sb][1]; const float T = e0[sb] * kp[sb][0];
            const float x1 = __shfl(T, (F.lane + 16) & 63), x2 = __shfl(T, (F.lane + 32) & 63), x3 = __shfl(T, (F.lane + 48) & 63);
            excl[sb] = (((g < 3) ? x1 : 1.0f) * ((g < 2) ? x2 : 1.0f)) * ((g < 1) ? x3 : 1.0f);
            TT[sb] = (T * ((g & 1) ? x3 : x1)) * (x2 * ((g & 1) ? x1 : x3)); }
        float off = run; bf16x8 X[2];
        { unsigned p[8];
#pragma unroll
          for (int sb = 3; sb >= 0; --sb) { const float base = off * excl[sb]; off *= TT[sb];
              const float a3 = base * sg[sb][3], a2 = base * kp[sb][3] * sg[sb][2], a1 = base * e1[sb] * sg[sb][1], a0 = base * e0[sb] * sg[sb][0];
              p[2 * sb] = pk2(a0, a1); p[2 * sb + 1] = pk2(a2, a3); }
          X[0] = __builtin_bit_cast(bf16x8, (v4u){p[0], p[1], p[2], p[3]}); X[1] = __builtin_bit_cast(bf16x8, (v4u){p[4], p[5], p[6], p[7]}); }
        run = off;
#pragma unroll
        for (int eb = 0; eb < 8; ++eb)
#pragma unroll
            for (int ks = 0; ks < 2; ++ks) { const LAS unsigned short* vp = LV + (32 * ks + 4 * g + (li >> 2)) * VR + 16 * eb + 4 * (li & 3);
                O[eb] = MFMA16(X[ks], tr_frag(vp, vp + 16 * VR), O[eb]); }
    }
}
__device__ __forceinline__ bool at_stage(Frame& F, AtRegs& R, const bf16* Pb, int kb, int tw, int lr, int lc, LAS unsigned short* LK, LAS unsigned short* LV, LAS unsigned* Lflag,
                                         const bf16x8 (&Qf)[4], f32x4 (&O)[8], float& run, bool& wdone, bool issue_next, AtRegs& Rn, v4u (&qn)[4], const bf16* Pbn, int tn, int qtn) {
    LDS_BARRIER();
    { unsigned all = 1u;
#pragma unroll
      for (int w = 0; w < 8; ++w) all &= Lflag[w];
      if (__builtin_amdgcn_readfirstlane(all)) return true; }
#pragma unroll
    for (int i = 0; i < 4; ++i) { const int r = lr + 32 * i; const unsigned ka[4] = {R.k[i].x, R.k[i].y, R.k[i].z, R.k[i].w}; float kv[8]; float ss = 0.f;
#pragma unroll
        for (int j = 0; j < 4; ++j) { kv[2 * j] = bflo(ka[j]); kv[2 * j + 1] = bfhi(ka[j]); ss += kv[2 * j] * kv[2 * j] + kv[2 * j + 1] * kv[2 * j + 1]; }
        ss = row16_sum(ss);
        const float rk = __builtin_amdgcn_rsqf(ss * (1.0f / HD) + EPS);
        *(LAS v4u*)(LK + r * TS + lc * 8) = (v4u){pk2(kv[0] * rk, kv[1] * rk), pk2(kv[2] * rk, kv[3] * rk), pk2(kv[4] * rk, kv[5] * rk), pk2(kv[6] * rk, kv[7] * rk)};
        *(LAS v4u*)(LV + r * VR + lc * 8) = R.v[i]; }
    LDS_BARRIER();
    at_issue(R, Pb, (kb >= 1) ? (kb - 1) : 0, lr, lc);
    if (issue_next) {
        const int g_ = F.lane >> 4;
#pragma unroll
        for (int kd = 0; kd < 4; ++kd) qn[kd] = *(const GAS v4u*)(Pbn + (size_t)tn * P16S + 4096 + 32 * kd + 8 * g_);
        at_issue(Rn, Pbn, qtn, lr, lc); }
    if (!wdone && (128 * kb + 64 <= tw + 14)) { at_half(F, 2 * kb + 1, 1, tw, LK + 64 * TS, LV + 64 * VR, Qf, O, run); wdone = __all(run < AT_STOP); }
    if (!wdone && (128 * kb <= tw + 14)) { at_half(F, 2 * kb, 0, tw, LK, LV, Qf, O, run); wdone = __all(run < AT_STOP); }
    if (kb == 0) wdone = true;
    if (wdone && F.lane == 0) Lflag[F.wave] = 1u;
    return false;
}
__device__ __forceinline__ void attn_all(Frame& F, const Args& args, int layer) {
    LAS unsigned short* LK = (LAS unsigned short*)(F.lds);
    LAS unsigned short* LV = LK + 128 * TS;
    LAS unsigned* Lflag = (LAS unsigned*)(LV + 128 * VR);
    LAS float* Lo = (LAS float*)(F.lds) + F.wave * (16 * 132);
    const int g = F.lane >> 4, li = F.lane & 15, lr = F.tid >> 4, lc = F.tid & 15;
    LAS float* Lgqk = (LAS float*)(Lflag + 16); LAS float* Log = Lgqk + 128;
    if (F.tid < 128) Lgqk[F.tid] = F_sb_q_g[layer * HD + F.tid] * F_sb_k_g[layer * HD + F.tid] * (0.08838834764831845f * 1.4426950408889634f);
    for (int i = F.tid; i < HGW; i += NWAVES * 64) Log[i] = F_sb_out_g[layer * HGW + i];
    LDS_BARRIER();
    AtRegs R0, Rn; v4u qraw[4], qn[4];
    int u = F.vcu;
    if (u < AT_UNITS) { const int bh_ = u >> 6, qt_ = u & 63; const bf16* Pb_ = F_P16 + (size_t)((bh_ >> 3) * SEQ) * P16S + (bh_ & 7) * HD; const int t_ = 128 * qt_ + 16 * F.wave + li;
#pragma unroll
        for (int kd = 0; kd < 4; ++kd) qraw[kd] = *(const GAS v4u*)(Pb_ + (size_t)t_ * P16S + 4096 + 32 * kd + 8 * g);
        at_issue(R0, Pb_, qt_, lr, lc); }
    while (u < AT_UNITS) {
        const int bh = u >> 6, qt = u & 63, b = bh >> 3, h = bh & 7, t0 = 128 * qt, tw = t0 + 16 * F.wave;
        const bf16* Pb = F_P16 + (size_t)(b * SEQ) * P16S + h * HD;
        const int un = u + F.G; const bool has_next = un < AT_UNITS;
        const int bhn = has_next ? (un >> 6) : bh, qtn = has_next ? (un & 63) : qt; const bf16* Pbn = F_P16 + (size_t)((bhn >> 3) * SEQ) * P16S + (bhn & 7) * HD; const int tn = 128 * qtn + 16 * F.wave + li;
        bf16x8 Qf[4];
        { float qv[32]; float ss = 0.f;
#pragma unroll
          for (int kd = 0; kd < 4; ++kd) { const unsigned a[4] = {qraw[kd].x, qraw[kd].y, qraw[kd].z, qraw[kd].w};
#pragma unroll
              for (int j = 0; j < 4; ++j) { const float lo = bflo(a[j]), hi = bfhi(a[j]); qv[8 * kd + 2 * j] = lo; qv[8 * kd + 2 * j + 1] = hi; ss += lo * lo + hi * hi; } }
          ss += __shfl_xor(ss, 16); ss += __shfl_xor(ss, 32);
          const float rq = __builtin_amdgcn_rsqf(ss * (1.0f / HD) + EPS);
#pragma unroll
          for (int kd = 0; kd < 4; ++kd) { unsigned p[4];
              const f32x4 c0 = *(const LAS f32x4*)(Lgqk + 32 * kd + 8 * g), c1 = *(const LAS f32x4*)(Lgqk + 32 * kd + 8 * g + 4); const float cc[8] = {c0.x, c0.y, c0.z, c0.w, c1.x, c1.y, c1.z, c1.w};
#pragma unroll
              for (int j = 0; j < 4; ++j) p[j] = pk2(qv[8 * kd + 2 * j] * rq * cc[2 * j], qv[8 * kd + 2 * j + 1] * rq * cc[2 * j + 1]);
              Qf[kd] = __builtin_bit_cast(bf16x8, (v4u){p[0], p[1], p[2], p[3]}); } }
        float run = 1.0f;
        f32x4 O[8];
#pragma unroll
        for (int eb = 0; eb < 8; ++eb) O[eb] = (f32x4){0.f, 0.f, 0.f, 0.f};
        bool wdone = false, issued = false;
        if (F.tid < 8) Lflag[F.tid] = 0u;
        for (int kb = qt; kb >= 0; --kb) {
            const bool inow = has_next && !issued && (kb == qt - 1 || kb == 0);
            if (at_stage(F, R0, Pb, kb, tw, lr, lc, LK, LV, Lflag, Qf, O, run, wdone, inow, Rn, qn, Pbn, tn, qtn)) break;
            issued = issued || inow;
        }
        LDS_BARRIER();
        if (has_next && !issued) {
#pragma unroll
            for (int kd = 0; kd < 4; ++kd) qn[kd] = *(const GAS v4u*)(Pbn + (size_t)tn * P16S + 4096 + 32 * kd + 8 * g);
            at_issue(Rn, Pbn, qtn, lr, lc); }
#pragma unroll
        for (int eb = 0; eb < 8; ++eb)
#pragma unroll
            for (int r = 0; r < 4; ++r) Lo[(4 * g + r) * 132 + 16 * eb + li] = O[eb][r];
        LDS_WAIT(); asm volatile("" ::: "memory");
        { const int rr = F.lane >> 2, es = 32 * (F.lane & 3); f32x4 ov[8]; float ss = 0.f;
#pragma unroll
          for (int i = 0; i < 8; ++i) { ov[i] = *(const LAS f32x4*)(Lo + rr * 132 + es + 4 * i); ss += (ov[i].x * ov[i].x + ov[i].y * ov[i].y) + (ov[i].z * ov[i].z + ov[i].w * ov[i].w); }
          ss = quad_sum(ss);
          const float ro = __builtin_amdgcn_rsqf(ss * (1.0f / HD) + EPS);
          GAS v4u* op = (GAS v4u*)(F_MIX + (size_t)(b * SEQ + tw + rr) * DM + HGW + h * HD + es);
#pragma unroll
          for (int i = 0; i < 4; ++i) { const f32x4 a0 = ov[2 * i] * ro * *(const LAS f32x4*)(Log + h * HD + es + 8 * i), a1 = ov[2 * i + 1] * ro * *(const LAS f32x4*)(Log + h * HD + es + 8 * i + 4);
              op[i] = (v4u){pk2(a0.x, a0.y), pk2(a0.z, a0.w), pk2(a1.x, a1.y), pk2(a1.z, a1.w)}; } }
        LDS_BARRIER();
#pragma unroll
        for (int kd = 0; kd < 4; ++kd) qraw[kd] = qn[kd];
        R0 = Rn;
        u = un;
    }
}
__global__ void __launch_bounds__(NWAVES * 64, 2) skel_fwd(Args args) {
    extern __shared__ __attribute__((aligned(16))) unsigned char lds[];
    Frame F;
    F.lds = (LAS unsigned char*)lds;
    F.MISC = (volatile LAS unsigned*)(F.lds + MISC_OFF);
    F.tid = threadIdx.x; F.lane = F.tid & 63; F.wave = __builtin_amdgcn_readfirstlane(F.tid >> 6);
    F.G = gridDim.x; { const int bx = blockIdx.x; F.vcu = (F.G % 8 == 0) ? (bx % 8) * (F.G / 8) + bx / 8 : bx; }
    unsigned char* ws = args.ws; F.ws = ws; F.out = args.out;
    F.ctl = (gu32*)(ws + WS_CTL);
    for (int u = F.tid; u < (LDS_BYTES - LDSCTL_OFF) / 4; u += NWAVES * 64) ((LAS unsigned*)(F.lds + LDSCTL_OFF))[u] = 0u;
    __syncthreads();
    XcdBarrier bar; bar.bar = (unsigned*)(F.ctl + CW_BAR); bar.x = 0; bar.st = nullptr;
    if (!MK_PER_PHASE) bar = xcd_barrier_post((unsigned*)(F.ctl + CW_BAR), F.MISC + 8);
#define GRID_BAR(seam) do { if (MK_PER_PHASE) { if (F.tid == 0) __hip_atomic_store(F.ctl + CW_TMO, 0xBADBA0u | (unsigned)(seam), RLX_AGENT); } else { XcdBarrier b_ = bar; unsigned* p_ = b_.bar; asm volatile("" : "+s"(p_)); b_.bar = p_; xcd_barrier(b_); } } while (0)
    const int lo = args.ph_lo, hi = args.ph_hi;
#define IN(k) (lo <= (k) && (k) < hi)
#define BOTH(k) (IN(k) && IN((k) + 1))

    if (IN(0)) { PHASE_FRAME(Fl); p0_prologue_a(Fl, args); if (BOTH(0)) GRID_BAR(0); }
    if (IN(1)) { PHASE_FRAME(Fl); p0_prologue_b(Fl, args); if (BOTH(1)) GRID_BAR(1); }
    if (IN(2)) { PHASE_FRAME(Fl); norm0_phase(Fl, F_x, F_norm1_g, F_MOD, DM, (long long*)(ws + WS_SS));
        { constexpr int NC = DEPTH * BATCH * (INC + 2 * DFF); const long long* cfx = (const long long*)(ws + WS_C1); float* cf = (float*)(ws + WS_CF);
          for (int i = Fl.vcu * (NWAVES * 64) + Fl.tid; i < NC; i += Fl.G * NWAVES * 64) cf[i] = pg8::fx_get(cfx + i, pg8::C_INV); }
        if (BOTH(2)) GRID_BAR(2); }

    for (int l = 0; l < DEPTH; ++l) {
        const int p0 = 3 + NPL * l;
        const float* xin = (l == 0) ? F_x : F.out;
        bf16* xa = (bf16*)(ws + WS_XA);
        const float* modl = F_MOD + (size_t)l * 2 * NMODC;
        const unsigned char* wt = ws + WS_WT + (size_t)l * WT_LAYER;
        long long* ss1 = (long long*)(ws + WS_SS) + (size_t)(2 * l) * M; long long* ss2 = ss1 + M;
        if (IN(p0 + 0)) {
            pg8::Gemm g{F_H, (const bf16*)(wt + WT_IN), M, INC, DM}; pg8::StaticOrder S; S.init(M, INC, F.G, (int)blockIdx.x);
            pg8::EpiProj E{F_P16, F_LB + l * HGW, ss1, (const float*)(ws + WS_CF) + (size_t)l * BATCH * INC, INC, SEQ};
            pg8::gemm_phase<pg8::EpiProj, pg8::StaticOrder, true, true>(F.lds + RING_OFF, g, S, E);
            if (BOTH(p0 + 0)) GRID_BAR(p0 + 0);
        }
        if (IN(p0 + 1)) {
            PHASE_FRAME(Fl);
            hgrn2_a1_all(Fl);
            attn_all(Fl, args, l);
            if (BOTH(p0 + 1)) GRID_BAR(p0 + 1);
        }
        if (IN(p0 + 2)) { PHASE_FRAME(Fl); hgrn2_a2(Fl); if (BOTH(p0 + 2)) GRID_BAR(p0 + 2); }
        if (IN(p0 + 3)) {
            PHASE_FRAME(Fl);
            hgrn2_a3_all(Fl, args, l);
            if (BOTH(p0 + 3)) GRID_BAR(p0 + 3);
        }
        if (IN(p0 + 4)) {
            pg8::Gemm g{F_MIX, (const bf16*)(wt + WT_OUT), M, DM, DM}; pg8::StaticOrder S; S.init(M, DM, F.G, (int)blockIdx.x);
            pg8::EpiResid<true, false> E{xin, nullptr, xa, modl + 2 * DM, NMODC, SEQ, F_H, F_norm2_g + l * DM, modl + 4 * DM, ss2};
            pg8::gemm_phase<pg8::EpiResid<true, false>, pg8::StaticOrder, false, true>(F.lds + RING_OFF, g, S, E);
            if (BOTH(p0 + 4)) GRID_BAR(p0 + 4);
        }
        if (IN(p0 + 5)) {
            pg8::Gemm g{F_H, (const bf16*)(wt + WT_FI), M, 2 * DFF, DM}; pg8::StaticOrder S; S.init(M, 2 * DFF, F.G, (int)blockIdx.x);
            pg8::EpiSwiGLU E{F_HID, DFF, ss2, (const float*)(ws + WS_CF) + (size_t)DEPTH * BATCH * INC + (size_t)l * BATCH * 2 * DFF, 2 * DFF, SEQ};
            pg8::gemm_phase<pg8::EpiSwiGLU, pg8::StaticOrder, true, true>(F.lds + RING_OFF, g, S, E);
            if (BOTH(p0 + 5)) GRID_BAR(p0 + 5);
        }
        if (IN(p0 + 6)) {
            pg8::Gemm g{F_HID, (const bf16*)(wt + WT_FO), M, DM, DFF}; pg8::StaticOrder S; S.init(M, DM, F.G, (int)blockIdx.x);
            const bool nxt = (l + 1 < DEPTH);
            pg8::EpiResid<false, true> E{xin, F.out, xa, modl + 5 * DM, NMODC, SEQ, nxt ? F_H : nullptr, F_norm1_g + (nxt ? l + 1 : l) * DM, F_MOD + (size_t)(nxt ? l + 1 : l) * 2 * NMODC + DM, nxt ? ss2 + M : ss2};
            pg8::gemm_phase<pg8::EpiResid<false, true>, pg8::StaticOrder, false, true>(F.lds + RING_OFF, g, S, E);
            if (BOTH(p0 + 6)) GRID_BAR(p0 + 6);
        }
    }
#undef IN
#undef BOTH
}

extern "C" void kernel_launch(void* const* d_in, const int* in_sizes, int n_in, void* d_out, int out_size, void* d_ws, size_t ws_size, hipStream_t stream) {
    static int grid = 0;
    if (grid == 0) {
        if (n_in != 15 || in_sizes[0] != M * DM || out_size != M * DM || ws_size < WS_END) { fprintf(stderr, "kernel_launch: unexpected shapes (n_in %d, in0 %d, out %d, ws %zu < %zu); nothing launched\n", n_in, n_in > 0 ? in_sizes[0] : -1, out_size, ws_size, (size_t)WS_END); grid = -1; return; }
        int dev = 0, cus = 0, per_cu = 0;
        if (hipGetDevice(&dev) != hipSuccess || hipDeviceGetAttribute(&cus, hipDeviceAttributeMultiprocessorCount, dev) != hipSuccess) { grid = -1; return; }
        if (hipFuncSetAttribute((const void*)skel_fwd, hipFuncAttributeMaxDynamicSharedMemorySize, LDS_BYTES) != hipSuccess) { fprintf(stderr, "kernel_launch: hipFuncSetAttribute failed\n"); grid = -1; return; }
        if (hipOccupancyMaxActiveBlocksPerMultiprocessor(&per_cu, (const void*)skel_fwd, NWAVES * 64, LDS_BYTES) != hipSuccess || per_cu < 1)
            fprintf(stderr, "kernel_launch: note: occupancy query reports %d workgroups per CU\n", per_cu);
        (void)hipGetLastError();
        grid = cus;
        if (grid > 256) grid = 256;
    }
    if (grid < 0) return;
    if (hipMemsetAsync((char*)d_ws + WS_CTL, 0, CTL_ZERO_BYTES, stream) != hipSuccess) return;
    Args a{};
    for (int i = 0; i < 15; ++i) a.in[i] = (const float*)d_in[i];
    a.out = (float*)d_out; a.ws = (unsigned char*)d_ws; a.li = 0; a.pad = 0;
#if MK_PER_PHASE
    for (int p = 0; p < NPH; ++p) { a.ph_lo = p; a.ph_hi = p + 1; hipLaunchKernelGGL(skel_fwd, dim3(grid), dim3(NWAVES * 64), LDS_BYTES, stream, a); }
#else
    a.ph_lo = 0; a.ph_hi = NPH;
    hipLaunchKernelGGL(skel_fwd, dim3(grid), dim3(NWAVES * 64), LDS_BYTES, stream, a);
#endif
}
```

```cpp
#include <hip/hip_runtime.h>
#include <cstdio>
#include <cstdint>
namespace pg8 {
#define PG8_LAS __attribute__((address_space(3)))
typedef unsigned short bf16_t;
typedef short bf16x8 __attribute__((ext_vector_type(8)));
typedef float f32x4 __attribute__((ext_vector_type(4)));
typedef unsigned u32x4 __attribute__((ext_vector_type(4)));
constexpr int BM = 256, BK = 64, HALF = 128, HTB = HALF * BK * 2  , STAGE_BYTES = 8 * HTB, NXCD = 8, WGM = 8;

__host__ __device__ __forceinline__ int lds_byte(int r, int c) { const int st = (r >> 4) * 2 + (c >> 5), rr = r & 15, cc = c & 31, ob = rr * 64 + cc * 2; return st * 1024 + (ob ^ (((ob >> 9) & 1) << 5)); }
__host__ __device__ __forceinline__ void stage_rc(int b, int& R, int& C) { const int st = b / 1024, sb = b % 1024, swz = sb ^ (((sb >> 9) & 1) << 5); R = (st >> 1) * 16 + swz / 64; C = (st & 1) * 32 + (swz % 64) / 2; }
__host__ __device__ __forceinline__ int perm32(int rho) { const int n = rho >> 4, i = rho & 15; return 8 * (i >> 2) + 4 * n + (i & 3); }

struct Unit { int pm, pn; };
struct Gemm { const bf16_t* A; const bf16_t* Bt; int M, N, K; };

struct StaticOrder {
    int nM, nN, nwg, G, c;
    __host__ __device__ void init(int M, int N, int G_, int c_) { nM = M / BM; nN = N / BM; nwg = nM * nN; G = G_; c = c_; }
    __host__ __device__ bool next(int i, Unit& u) const {
        const long L = (long)i * G + c; if (L >= nwg) return false;
        int wgid = (int)L; { const int q = nwg / NXCD, r = nwg % NXCD, xcd = wgid % NXCD, off = wgid / NXCD; wgid = (xcd < r ? xcd * (q + 1) : r * (q + 1) + (xcd - r) * q) + off; }
        const int nig = WGM * nN, gid = wgid / nig, fm = gid * WGM, gsz = (nM - fm) < WGM ? (nM - fm) : WGM;
        u.pm = fm + ((wgid % nig) % gsz); u.pn = (wgid % nig) / gsz; return true;
    }
    __device__ __forceinline__ void a_ready(const Unit&) const {}
    __device__ __forceinline__ void done(const Unit&) const {}
};

__device__ __forceinline__ unsigned cvt_pk_bf16(float lo, float hi) { unsigned r; asm volatile("v_cvt_pk_bf16_f32 %0, %1, %2" : "=v"(r) : "v"(lo), "v"(hi)); return r; }
__device__ __forceinline__ unsigned cvt_pk_f16(float lo, float hi) { typedef _Float16 h2 __attribute__((ext_vector_type(2))); h2 v; v.x = (_Float16)lo; v.y = (_Float16)hi; return __builtin_bit_cast(unsigned, v); }
__device__ __forceinline__ float fsilu(float x) { return x * __builtin_amdgcn_rcpf(1.0f + __expf(-x)); }
__device__ __forceinline__ f32x4 fsilu4(f32x4 x) {
    f32x4 e = x * -1.4426950408889634f;
#pragma unroll
    for (int j = 0; j < 4; ++j) e[j] = __builtin_amdgcn_exp2f(e[j]);
    f32x4 d = e + 1.0f;
#pragma unroll
    for (int j = 0; j < 4; ++j) d[j] = __builtin_amdgcn_rcpf(d[j]);
    return x * d;
}

constexpr int P16_LD = 8192;
constexpr float RMS_EPS = 1e-6f;
__device__ __forceinline__ void fx_add(long long* p, float v, float scale) { atomicAdd((unsigned long long*)p, (unsigned long long)__float2ll_rn(v * scale)); }
__device__ __forceinline__ float fx_get(const long long* p, float inv_scale) { return (float)(*p) * inv_scale; }
constexpr float SS_SCALE = 65536.0f, SS_INV = 1.0f / 65536.0f, C_SCALE = 4294967296.0f, C_INV = 1.0f / 4294967296.0f;
struct EpiProj {
    static constexpr bool PERM = true, AFTER_DRAIN = false;
    bf16_t* P; const float* lb;
    const long long* ss; const float* cvec; int cstride, rows_per_batch;
    __device__ __forceinline__ void operator()(const f32x4 (&acc)[2][2][4][2], const Unit& u, int wr, int wc, int fr, int fq) const {
        const int sec = u.pn >> 2;
        const int row0 = u.pm * BM + wr * 64 + fr, col0 = u.pn * BM + wc * 32 + 8 * fq;
        const float* cb = cvec + (size_t)((u.pm * BM) / rows_per_batch) * cstride + col0;
        const float* lbp = lb + ((sec == 1) ? (col0 - 1024) : 0);
        long long sv[2][4]; f32x4 cc[2][2], ll[2][2];
#pragma unroll
        for (int ai = 0; ai < 2; ++ai)
#pragma unroll
            for (int m = 0; m < 4; ++m) sv[ai][m] = ss[row0 + ai * HALF + m * 16];
#pragma unroll
        for (int bj = 0; bj < 2; ++bj) { cc[bj][0] = *(const f32x4*)(cb + bj * HALF); cc[bj][1] = *(const f32x4*)(cb + bj * HALF + 4);
            ll[bj][0] = *(const f32x4*)(lbp + bj * HALF); ll[bj][1] = *(const f32x4*)(lbp + bj * HALF + 4); }
        asm volatile("" : "+v"(sv[0][0]), "+v"(sv[0][1]), "+v"(sv[0][2]), "+v"(sv[0][3]), "+v"(sv[1][0]), "+v"(sv[1][1]), "+v"(sv[1][2]), "+v"(sv[1][3]),
                          "+v"(cc[0][0]), "+v"(cc[0][1]), "+v"(cc[1][0]), "+v"(cc[1][1]), "+v"(ll[0][0]), "+v"(ll[0][1]), "+v"(ll[1][0]), "+v"(ll[1][1]));
        float rstd[2][4];
#pragma unroll
        for (int ai = 0; ai < 2; ++ai)
#pragma unroll
            for (int m = 0; m < 4; ++m) rstd[ai][m] = __builtin_amdgcn_rsqf((float)sv[ai][m] * (SS_INV * (1.0f / 2048.0f)) + RMS_EPS);
#pragma unroll
        for (int bj = 0; bj < 2; ++bj) {
            const f32x4 c0 = cc[bj][0], c1 = cc[bj][1];
            if (sec == 1) {
                const f32x4 l0 = ll[bj][0], l1 = ll[bj][1];
#pragma unroll
                for (int ai = 0; ai < 2; ++ai)
#pragma unroll
                    for (int m = 0; m < 4; ++m) { bf16_t* rowp = P + (size_t)(row0 + ai * HALF + m * 16) * P16_LD + col0 + bj * HALF; float lf[8];
#pragma unroll
                        for (int j = 0; j < 4; ++j) { const float fl0 = acc[ai][bj][m][0][j] * rstd[ai][m] + c0[j], fl1 = acc[ai][bj][m][1][j] * rstd[ai][m] + c1[j];
                            const float r0 = __builtin_amdgcn_rcpf(1.0f + __expf(-fl0)), r1 = __builtin_amdgcn_rcpf(1.0f + __expf(-fl1));
                            lf[j] = 0.6931471805599453f * __builtin_amdgcn_logf(fmaxf(l0[j] + (1.0f - l0[j]) * r0, 1e-30f)); lf[4 + j] = 0.6931471805599453f * __builtin_amdgcn_logf(fmaxf(l1[j] + (1.0f - l1[j]) * r1, 1e-30f)); }
                        u32x4 w; w.x = cvt_pk_f16(lf[0], lf[1]); w.y = cvt_pk_f16(lf[2], lf[3]); w.z = cvt_pk_f16(lf[4], lf[5]); w.w = cvt_pk_f16(lf[6], lf[7]);
                        *(u32x4*)(rowp) = w; }
            } else {
                const bool act = (sec == 0) || (sec == 3);
#pragma unroll
                for (int ai = 0; ai < 2; ++ai)
#pragma unroll
                    for (int m = 0; m < 4; ++m) { bf16_t* rowp = P + (size_t)(row0 + ai * HALF + m * 16) * P16_LD + col0 + bj * HALF;
                        f32x4 v0 = acc[ai][bj][m][0] * rstd[ai][m] + c0, v1 = acc[ai][bj][m][1] * rstd[ai][m] + c1;
                        if (act) { v0 = fsilu4(v0); v1 = fsilu4(v1); }
                        u32x4 w; w.x = cvt_pk_bf16(v0[0], v0[1]); w.y = cvt_pk_bf16(v0[2], v0[3]); w.z = cvt_pk_bf16(v1[0], v1[1]); w.w = cvt_pk_bf16(v1[2], v1[3]);
                        *(u32x4*)(rowp) = w; }
            }
        }
    }
};
template <bool OUT_DELTA, bool HAS_DIN> struct EpiResid {
    static constexpr bool PERM = true, AFTER_DRAIN = false;
    const float* base; float* out; bf16_t* dbuf; const float* gate; int gate_bstride, rows_per_batch;
    bf16_t* Hn; const float* gnext; const float* scnext; long long* ssn;
    __device__ __forceinline__ void operator()(const f32x4 (&acc)[2][2][4][2], const Unit& u, int wr, int wc, int fr, int fq) const {
        const int row0 = u.pm * BM + wr * 64 + fr, col0 = u.pn * BM + wc * 32 + 8 * fq, b = (u.pm * BM) / rows_per_batch;
        const float* g = gate + (size_t)b * gate_bstride + col0;
        float ssq[2][4];
#pragma unroll
        for (int ai = 0; ai < 2; ++ai)
#pragma unroll
            for (int m = 0; m < 4; ++m) ssq[ai][m] = 0.f;
        f32x4 gv[2][2], Gv[2][2];
#pragma unroll
        for (int bj = 0; bj < 2; ++bj) { gv[bj][0] = *(const f32x4*)(g + bj * HALF); gv[bj][1] = *(const f32x4*)(g + bj * HALF + 4); Gv[bj][0] = (f32x4){0.f, 0.f, 0.f, 0.f}; Gv[bj][1] = (f32x4){0.f, 0.f, 0.f, 0.f};
            if (Hn) { const float* sc = scnext + (size_t)b * gate_bstride + col0 + bj * HALF;
                Gv[bj][0] = *(const f32x4*)(gnext + col0 + bj * HALF) * (1.0f + *(const f32x4*)(sc)); Gv[bj][1] = *(const f32x4*)(gnext + col0 + bj * HALF + 4) * (1.0f + *(const f32x4*)(sc + 4)); } }
#pragma unroll
        for (int bj = 0; bj < 2; ++bj) {
            const f32x4 g0 = gv[bj][0], g1 = gv[bj][1], G0 = Gv[bj][0], G1 = Gv[bj][1];
#pragma unroll
            for (int ai = 0; ai < 2; ++ai)
#pragma unroll
                for (int m = 0; m < 4; ++m) { const size_t off = (size_t)(row0 + ai * HALF + m * 16) * 2048 + col0 + bj * HALF;
                    f32x4 x0 = __builtin_nontemporal_load((const f32x4*)(base + off)), x1 = __builtin_nontemporal_load((const f32x4*)(base + off + 4));
                    if constexpr (HAS_DIN) { const u32x4 dw = __builtin_nontemporal_load((const u32x4*)(dbuf + off));
                        x0 += (f32x4){__builtin_bit_cast(float, dw.x << 16), __builtin_bit_cast(float, dw.x & 0xffff0000u), __builtin_bit_cast(float, dw.y << 16), __builtin_bit_cast(float, dw.y & 0xffff0000u)};
                        x1 += (f32x4){__builtin_bit_cast(float, dw.z << 16), __builtin_bit_cast(float, dw.z & 0xffff0000u), __builtin_bit_cast(float, dw.w << 16), __builtin_bit_cast(float, dw.w & 0xffff0000u)}; }
                    f32x4 o0, o1;
                    if constexpr (OUT_DELTA) { const f32x4 d0 = g0 * acc[ai][bj][m][0], d1 = g1 * acc[ai][bj][m][1];
                        u32x4 w; w.x = cvt_pk_bf16(d0[0], d0[1]); w.y = cvt_pk_bf16(d0[2], d0[3]); w.z = cvt_pk_bf16(d1[0], d1[1]); w.w = cvt_pk_bf16(d1[2], d1[3]);
                        *(u32x4*)(dbuf + off) = w;
                        o0 = x0 + (f32x4){__builtin_bit_cast(float, w.x << 16), __builtin_bit_cast(float, w.x & 0xffff0000u), __builtin_bit_cast(float, w.y << 16), __builtin_bit_cast(float, w.y & 0xffff0000u)};
                        o1 = x1 + (f32x4){__builtin_bit_cast(float, w.z << 16), __builtin_bit_cast(float, w.z & 0xffff0000u), __builtin_bit_cast(float, w.w << 16), __builtin_bit_cast(float, w.w & 0xffff0000u)}; }
                    else { o0 = x0 + g0 * acc[ai][bj][m][0]; o1 = x1 + g1 * acc[ai][bj][m][1]; *(f32x4*)(out + off) = o0; *(f32x4*)(out + off + 4) = o1; }
                    if (Hn) { const f32x4 h0 = o0 * G0, h1 = o1 * G1;
                        u32x4 w; w.x = cvt_pk_bf16(h0[0], h0[1]); w.y = cvt_pk_bf16(h0[2], h0[3]); w.z = cvt_pk_bf16(h1[0], h1[1]); w.w = cvt_pk_bf16(h1[2], h1[3]);
                        *(u32x4*)(Hn + off) = w;
                        ssq[ai][m] += ((o0[0] * o0[0] + o0[1] * o0[1]) + (o0[2] * o0[2] + o0[3] * o0[3])) + ((o1[0] * o1[0] + o1[1] * o1[1]) + (o1[2] * o1[2] + o1[3] * o1[3])); } }
            if (bj == 0) asm volatile("" ::: "memory");
        }
        if (Hn) {
#pragma unroll
            for (int ai = 0; ai < 2; ++ai)
#pragma unroll
                for (int m = 0; m < 4; ++m) { float s = ssq[ai][m]; s += __shfl_xor(s, 16); s += __shfl_xor(s, 32);
                    if (fq == 0) fx_add(ssn + row0 + ai * HALF + m * 16, s, SS_SCALE); } }
    }
};
struct EpiSwiGLU {
    static constexpr bool PERM = true, AFTER_DRAIN = false;
    bf16_t* Hd; int ldh;
    const long long* ss; const float* cvec; int cstride, rows_per_batch;
    __device__ __forceinline__ void operator()(const f32x4 (&acc)[2][2][4][2], const Unit& u, int wr, int wc, int fr, int fq) const {
        const int row0 = u.pm * BM + wr * 64 + fr, col0 = u.pn * HALF + wc * 32 + 8 * fq;
        const float* cb = cvec + (size_t)((u.pm * BM) / rows_per_batch) * cstride + u.pn * BM + wc * 32 + 8 * fq;
        long long sv[2][4];
#pragma unroll
        for (int ai = 0; ai < 2; ++ai)
#pragma unroll
            for (int m = 0; m < 4; ++m) sv[ai][m] = ss[row0 + ai * HALF + m * 16];
        f32x4 cg0 = *(const f32x4*)(cb), cg1 = *(const f32x4*)(cb + 4), cu0 = *(const f32x4*)(cb + HALF), cu1 = *(const f32x4*)(cb + HALF + 4);
        asm volatile("" : "+v"(sv[0][0]), "+v"(sv[0][1]), "+v"(sv[0][2]), "+v"(sv[0][3]), "+v"(sv[1][0]), "+v"(sv[1][1]), "+v"(sv[1][2]), "+v"(sv[1][3]), "+v"(cg0), "+v"(cg1), "+v"(cu0), "+v"(cu1));
#pragma unroll
        for (int ai = 0; ai < 2; ++ai)
#pragma unroll
            for (int m = 0; m < 4; ++m) { bf16_t* rowp = Hd + (size_t)(row0 + ai * HALF + m * 16) * ldh + col0;
                const float rstd = __builtin_amdgcn_rsqf((float)sv[ai][m] * (SS_INV * (1.0f / 2048.0f)) + RMS_EPS);
                const f32x4 ga = acc[ai][0][m][0] * rstd + cg0, gb = acc[ai][0][m][1] * rstd + cg1, ua = acc[ai][1][m][0] * rstd + cu0, ub = acc[ai][1][m][1] * rstd + cu1;
                const f32x4 v0 = fsilu4(ga) * ua, v1 = fsilu4(gb) * ub;
                u32x4 w; w.x = cvt_pk_bf16(v0[0], v0[1]); w.y = cvt_pk_bf16(v0[2], v0[3]); w.z = cvt_pk_bf16(v1[0], v1[1]); w.w = cvt_pk_bf16(v1[2], v1[3]);
                *(u32x4*)rowp = w; }
    }
};

template <class Epi, class Sched, bool ALIGN_EPI = false, bool SP2 = false>
__device__ __forceinline__ void gemm_phase(PG8_LAS unsigned char* lds, const Gemm g, const Sched& S, const Epi& E) {
    int tid_ = threadIdx.x; asm volatile("" : "+v"(tid_));
    const int tid = tid_, wid = __builtin_amdgcn_readfirstlane(tid >> 6), lane = tid & 63, wr = wid >> 2, wc = wid & 3, fr = lane & 15, fq = lane >> 4;
    const int K = g.K, nt = K / BK;
    unsigned voffA[2], voffB[2];
#pragma unroll
    for (int i = 0; i < 2; ++i) { int R, C; stage_rc(tid * 16 + i * 8192, R, C); const int Rb = Epi::PERM ? ((R & ~31) + perm32(R & 31)) : R;
        voffA[i] = (unsigned)(R * K + C) * 2u; voffB[i] = (unsigned)(Rb * K + C) * 2u; }
    const size_t kstep = (size_t)(BK * 2);
    const size_t hstep = (size_t)HALF * K * 2;
    const size_t tstep = 2 * hstep;
    const unsigned ldsw = (unsigned)wid * 1024u;
    const int aoff = lds_byte(wr * 64 + fr, fq * 8), boff = lds_byte(wc * 32 + fr, fq * 8);
#define PG8_SA(b, h) (((b) * 2 + (h)) * HTB)
#define PG8_SB(b, h) ((4 + (b) * 2 + (h)) * HTB)
#define PG8_STAGE(bufoff, gbase, voff) do { const char* gb_ = (const char*)(gbase); asm volatile("" : "+s"(gb_)); _Pragma("unroll") for (int _i = 0; _i < 2; ++_i) { unsigned vo_ = (voff)[_i]; asm volatile("" : "+v"(vo_));        \
        __builtin_amdgcn_global_load_lds((const unsigned*)(gb_ + vo_), (PG8_LAS unsigned*)(lds + (bufoff) + ldsw + _i * 8192), 16, 0, 0); } } while (0)
#define PG8_LDA(dst, b, h) do { _Pragma("unroll") for (int m = 0; m < 4; ++m) _Pragma("unroll") for (int k = 0; k < 2; ++k) dst[m][k] = *(const PG8_LAS bf16x8*)(lds + PG8_SA(b, h) + aoff + m * 2048 + k * 1024); } while (0)
#define PG8_LDB(dst, b, h) do { _Pragma("unroll") for (int n = 0; n < 2; ++n) _Pragma("unroll") for (int k = 0; k < 2; ++k) dst[n][k] = *(const PG8_LAS bf16x8*)(lds + PG8_SB(b, h) + boff + n * 2048 + k * 1024); } while (0)
#define PG8_MMA(ai, bj, At, Bt) do { __builtin_amdgcn_s_setprio(1); _Pragma("unroll") for (int m = 0; m < 4; ++m) _Pragma("unroll") for (int n = 0; n < 2; ++n) _Pragma("unroll") for (int k = 0; k < 2; ++k) \
        acc[ai][bj][m][n] = __builtin_amdgcn_mfma_f32_16x16x32_bf16(Bt[n][k], At[m][k], acc[ai][bj][m][n], 0, 0, 0); __builtin_amdgcn_s_setprio(0); } while (0)
#define PG8_WAIT_V(n) asm volatile("s_waitcnt vmcnt(" #n ")" ::: "memory")
#define PG8_WAIT_L(n) asm volatile("s_waitcnt lgkmcnt(" #n ")" ::: "memory")
#define PG8_BAR __builtin_amdgcn_s_barrier()
#define PG8_SCHED __builtin_amdgcn_sched_barrier(0)
    Unit cur, nxt; int ui = 0;
    if (!S.next(0, cur)) return;
    f32x4 acc[2][2][4][2];
#pragma unroll
    for (int a = 0; a < 2; ++a)
#pragma unroll
        for (int b = 0; b < 2; ++b)
#pragma unroll
            for (int m = 0; m < 4; ++m)
#pragma unroll
                for (int n = 0; n < 2; ++n) acc[a][b][m][n] = (f32x4){0.f, 0.f, 0.f, 0.f};
    bf16x8 At[4][2], B0[2][2], B1[2][2];
    const char* cA = (const char*)g.A + (size_t)cur.pm * tstep; const char* cB = (const char*)g.Bt + (size_t)cur.pn * tstep;
    S.a_ready(cur);
    if constexpr (SP2) {
        PG8_STAGE(PG8_SB(0, 0), cB, voffB); PG8_STAGE(PG8_SB(0, 1), cB + hstep, voffB); PG8_STAGE(PG8_SA(0, 0), cA, voffA); PG8_STAGE(PG8_SA(0, 1), cA + hstep, voffA);
        if (wr == 1) PG8_BAR;
        PG8_WAIT_V(2); PG8_BAR;
        PG8_STAGE(PG8_SB(1, 0), cB + kstep, voffB); PG8_STAGE(PG8_SA(1, 0), cA + kstep, voffA); PG8_STAGE(PG8_SB(1, 1), cB + hstep + kstep, voffB);
        PG8_WAIT_V(6); PG8_BAR;
    } else {
        PG8_STAGE(PG8_SB(0, 0), cB, voffB); PG8_STAGE(PG8_SA(0, 0), cA, voffA); PG8_STAGE(PG8_SB(0, 1), cB + hstep, voffB); PG8_STAGE(PG8_SA(0, 1), cA + hstep, voffA);
        if (wr == 1) PG8_BAR;
        PG8_WAIT_V(4); PG8_BAR;
        PG8_STAGE(PG8_SB(1, 0), cB + kstep, voffB); PG8_STAGE(PG8_SA(1, 0), cA + kstep, voffA); PG8_STAGE(PG8_SB(1, 1), cB + hstep + kstep, voffB);
        PG8_WAIT_V(6); PG8_BAR;
    }
    for (;;) {
        const bool has_next = S.next(ui + 1, nxt);
        const char* nA = has_next ? (const char*)g.A + (size_t)nxt.pm * tstep : cA; const char* nB = has_next ? (const char*)g.Bt + (size_t)nxt.pn * tstep : cB;
        for (int t = 0; t < nt; t += 2) {
            const bool last = (t == nt - 2);
            const char* a1 = cA + (size_t)(t + 1) * kstep;
            const char* a2 = last ? nA : cA + (size_t)(t + 2) * kstep; const char* b2 = last ? nB : cB + (size_t)(t + 2) * kstep;
            const char* a3 = a2 + kstep; const char* b3 = b2 + kstep;
            if (last && has_next) S.a_ready(nxt);
            if constexpr (SP2) {
            PG8_LDB(B0, 0, 0); PG8_LDB(B1, 0, 1); PG8_SCHED; PG8_LDA(At, 0, 0); PG8_STAGE(PG8_SA(1, 1), a1 + hstep, voffA);
            PG8_WAIT_V(8); PG8_WAIT_L(0); PG8_BAR; PG8_MMA(0, 0, At, B0); PG8_MMA(0, 1, At, B1); PG8_BAR; PG8_SCHED;
            PG8_LDA(At, 0, 1); PG8_STAGE(PG8_SB(0, 0), b2, voffB); PG8_STAGE(PG8_SB(0, 1), b2 + hstep, voffB); PG8_STAGE(PG8_SA(0, 0), a2, voffA);
            PG8_WAIT_V(8); PG8_WAIT_L(0); PG8_BAR; PG8_MMA(1, 0, At, B0); PG8_MMA(1, 1, At, B1); PG8_BAR; PG8_SCHED;
            PG8_LDB(B0, 1, 0); PG8_LDB(B1, 1, 1); PG8_SCHED; PG8_LDA(At, 1, 0); PG8_STAGE(PG8_SA(0, 1), a2 + hstep, voffA);
            PG8_WAIT_V(8); PG8_WAIT_L(0); PG8_BAR; PG8_MMA(0, 0, At, B0); PG8_MMA(0, 1, At, B1); PG8_BAR; PG8_SCHED;
            PG8_LDA(At, 1, 1); PG8_STAGE(PG8_SB(1, 0), b3, voffB); PG8_STAGE(PG8_SB(1, 1), b3 + hstep, voffB); PG8_STAGE(PG8_SA(1, 0), a3, voffA);
            PG8_WAIT_V(8); PG8_WAIT_L(0); PG8_BAR; PG8_MMA(1, 0, At, B0); PG8_MMA(1, 1, At, B1); PG8_BAR; PG8_SCHED;
            } else {
            PG8_LDB(B0, 0, 0); PG8_SCHED; PG8_LDA(At, 0, 0); PG8_STAGE(PG8_SA(1, 1), a1 + hstep, voffA);
            PG8_WAIT_L(8); PG8_BAR; PG8_WAIT_L(0); PG8_MMA(0, 0, At, B0); PG8_BAR; PG8_SCHED;
            PG8_LDB(B1, 0, 1); PG8_STAGE(PG8_SB(0, 0), b2, voffB);
            PG8_BAR; PG8_WAIT_L(0); PG8_MMA(0, 1, At, B1); PG8_BAR;
            PG8_LDA(At, 0, 1); PG8_STAGE(PG8_SA(0, 0), a2, voffA);
            PG8_BAR; PG8_WAIT_L(0); PG8_MMA(1, 0, At, B0); PG8_BAR; PG8_SCHED;
            PG8_STAGE(PG8_SB(0, 1), b2 + hstep, voffB);
            PG8_WAIT_V(6); PG8_BAR; PG8_MMA(1, 1, At, B1); PG8_BAR;
            PG8_LDB(B0, 1, 0); PG8_SCHED; PG8_LDA(At, 1, 0); PG8_STAGE(PG8_SA(0, 1), a2 + hstep, voffA);
            PG8_WAIT_L(8); PG8_BAR; PG8_WAIT_L(0); PG8_MMA(0, 0, At, B0); PG8_BAR; PG8_SCHED;
            PG8_LDB(B1, 1, 1); PG8_STAGE(PG8_SB(1, 0), b3, voffB);
            PG8_BAR; PG8_WAIT_L(0); PG8_MMA(0, 1, At, B1); PG8_BAR;
            PG8_LDA(At, 1, 1); PG8_STAGE(PG8_SA(1, 0), a3, voffA);
            PG8_BAR; PG8_WAIT_L(0); PG8_MMA(1, 0, At, B0); PG8_BAR; PG8_SCHED;
            PG8_STAGE(PG8_SB(1, 1), b3 + hstep, voffB);
            PG8_WAIT_V(6); PG8_BAR; PG8_MMA(1, 1, At, B1); PG8_BAR;
            }
        }
        if constexpr (ALIGN_EPI) { if (wr == 0) PG8_BAR; }
        if constexpr (!Epi::AFTER_DRAIN) { E(acc, cur, wr, wc, fr, fq); S.done(cur); }
        if (!has_next) break;
#pragma unroll
        for (int a = 0; a < 2; ++a)
#pragma unroll
            for (int b = 0; b < 2; ++b)
#pragma unroll
                for (int m = 0; m < 4; ++m)
#pragma unroll
                    for (int n = 0; n < 2; ++n) acc[a][b][m][n] = (f32x4){0.f, 0.f, 0.f, 0.f};
        cur = nxt; cA = nA; cB = nB; ++ui;
        if constexpr (ALIGN_EPI) { if (wr == 1) PG8_BAR; }
    }
    PG8_WAIT_V(0);
    if constexpr (!ALIGN_EPI) { if (wr == 0) PG8_BAR; }
    PG8_BAR;
    if constexpr (Epi::AFTER_DRAIN) { E.fused(acc, cur, wr, wc, fr, fq, lds, wid, lane); S.done(cur); }
#undef PG8_SA
#undef PG8_SB
#undef PG8_STAGE
#undef PG8_LDA
#undef PG8_LDB
#undef PG8_MMA
#undef PG8_WAIT_V
#undef PG8_WAIT_L
#undef PG8_BAR
#undef PG8_SCHED
}
}

constexpr int NWAVES = 8;
#ifndef MK_PER_PHASE
#define MK_PER_PHASE 0
#endif
constexpr int BATCH = 2, SEQ = 8192, DM = 2048, DEPTH = 4, M = BATCH * SEQ, INC = 7168, DFF = 5632, NMODC = 6 * DM;
constexpr int HGW = 1024, HD = 128, NH = 8;
constexpr float EPS = 1e-6f;
constexpr int NPL = 7;
constexpr int NPH = 3 + DEPTH * NPL;

constexpr size_t MiB = 1u << 20;
constexpr size_t WS_CTL = 0, CTL_ZERO_BYTES = 3 * MiB;
constexpr size_t WS_SS = 256 * 1024;
constexpr size_t WS_C1 = 256 * 1024 + 1024 * 1024;
constexpr size_t WS_C2 = WS_C1 + (size_t)DEPTH * BATCH * INC * 8;
static_assert(WS_C2 + (size_t)DEPTH * BATCH * 2 * DFF * 8 <= CTL_ZERO_BYTES, "accumulators inside the memset region");
constexpr size_t WS_MOD = 3 * MiB;
constexpr size_t WS_CF = 4 * MiB;
constexpr size_t WS_LB = 3 * MiB + 512 * 1024;
constexpr size_t WS_WT = 5 * MiB, WT_LAYER = 102 * MiB;
constexpr size_t WT_IN = 0, WT_OUT = 28 * MiB, WT_FI = 36 * MiB, WT_FO = 80 * MiB;
constexpr size_t WS_H = WS_WT + DEPTH * WT_LAYER;
constexpr size_t WS_P16 = WS_H + 64 * MiB;
constexpr size_t WS_MIX = WS_P16 + 256 * MiB;
constexpr size_t WS_HID = WS_MIX + 64 * MiB;
constexpr size_t WS_SLOC = WS_HID + 176 * MiB;
constexpr size_t WS_DEC = WS_SLOC + 64 * MiB;
constexpr size_t WS_XA = WS_DEC + 1 * MiB;
constexpr size_t WS_SPREV = WS_XA + 64 * MiB;
constexpr size_t WS_END = WS_SPREV + 64 * MiB;
static_assert((size_t)INC * DM * 2 == 28 * MiB && (size_t)DM * DM * 2 == 8 * MiB && (size_t)2 * DFF * DM * 2 == 44 * MiB && (size_t)DM * DFF * 2 == 22 * MiB, "weight copy sizes");
static_assert((size_t)M * DFF * 2 == 176 * MiB && (size_t)M * 8192 * 2 == 256 * MiB, "activation sizes");
constexpr int CW_TMO = 0, CW_CODE = 1;
constexpr int CW_BAR = 4096;
constexpr int CW_A1 = 8192;

constexpr int RING_OFF = 0, RING_BYTES = 131072;
constexpr int LDSCTL_OFF = RING_BYTES, MISC_OFF = LDSCTL_OFF + 320;
constexpr int LDS_BYTES = 147456;
static_assert(MISC_OFF + 128 <= LDS_BYTES, "LDS map");

#define GAS __attribute__((address_space(1)))
#define LAS __attribute__((address_space(3)))
typedef unsigned short bf16;
typedef unsigned v4u __attribute__((ext_vector_type(4)));
typedef unsigned v2u __attribute__((ext_vector_type(2)));
typedef float f32x4 __attribute__((ext_vector_type(4)));
typedef float f32x2 __attribute__((ext_vector_type(2)));
typedef GAS unsigned gu32;
typedef GAS unsigned long long gu64;
#define RLX_AGENT __ATOMIC_RELAXED, __HIP_MEMORY_SCOPE_AGENT
#define LDS_WAIT() asm volatile("s_waitcnt lgkmcnt(0)" ::: "memory")
#define VM_WAIT() asm volatile("s_waitcnt vmcnt(0)" ::: "memory")
__device__ __forceinline__ unsigned f2bf(float f) { unsigned u = __builtin_bit_cast(unsigned, f); return (u + 0x7fffu + ((u >> 16) & 1u)) >> 16; }
typedef float f32x2_t_ __attribute__((ext_vector_type(2))); typedef __bf16 bf16x2_t_ __attribute__((ext_vector_type(2)));
__device__ __forceinline__ unsigned pk2(float lo, float hi) { const f32x2_t_ v = {lo, hi}; const bf16x2_t_ b = __builtin_convertvector(v, bf16x2_t_); return __builtin_bit_cast(unsigned, b); }
__device__ __forceinline__ float bflo(unsigned w) { return __builtin_bit_cast(float, w << 16); }
__device__ __forceinline__ float bfhi(unsigned w) { return __builtin_bit_cast(float, w & 0xffff0000u); }
__device__ __forceinline__ float h2f(unsigned short hbits) { return (float)__builtin_bit_cast(_Float16, hbits); }

#define XB_TMO      128
#define XB_XCNT(j)  (256  + 64 * (j))
#define XB_XSUB(j)  (1280 + 64 * (j))
#define XB_XGEN(j)  (2304 + 64 * (j))
#define XB_TOP      3328
#define XB_TOPGEN   3392
#define XCD_BAR_WORDS 3456
#define XB_SPIN_CAP (1u << 18)

__device__ __forceinline__ unsigned xb_ld(unsigned* p)              { return __hip_atomic_load(p, __ATOMIC_RELAXED, __HIP_MEMORY_SCOPE_AGENT); }
__device__ __forceinline__ unsigned xb_add(unsigned* p, unsigned v) { return __hip_atomic_fetch_add(p, v, __ATOMIC_RELAXED, __HIP_MEMORY_SCOPE_AGENT); }
__device__ __forceinline__ unsigned xb_xcc_id() { return (unsigned)__builtin_amdgcn_s_getreg((3 << 11) | 20) & 0xFu; }
#define XB_SPIN(cond, bar) do { unsigned _sp = 0; while (cond) { __builtin_amdgcn_s_sleep(1); \
    if ((++_sp & 255u) == 0u) { if (xb_ld(&(bar)[XB_TMO])) break; if (_sp > XB_SPIN_CAP) { atomicAdd(&(bar)[XB_TMO], 1u); break; } } } } while (0)

struct XcdBarrier {
    unsigned* bar; unsigned x;
    volatile LAS unsigned* st;
};

__device__ __forceinline__ XcdBarrier xcd_barrier_post(unsigned* bar, volatile LAS unsigned* st) {
    XcdBarrier b; b.bar = bar; b.x = xb_xcc_id(); b.st = st;
    if (threadIdx.x == 0) (void)xb_add(&bar[XB_XCNT(b.x)], 1u);
    return b;
}
__device__ __forceinline__ void xcd_barrier_complete(unsigned* bar, unsigned x, unsigned& nloc, unsigned& nx) {
    const unsigned G = gridDim.x * gridDim.y * gridDim.z;
    unsigned sum, cnt, mine, sp = 0u;
    for (;;) {
        sum = 0u; cnt = 0u; mine = 0u;
#pragma unroll
        for (unsigned j = 0; j < 16; ++j) { const unsigned c = xb_ld(&bar[XB_XCNT(j)]); sum += c; cnt += (c > 0u) ? 1u : 0u; mine = (j == x) ? c : mine; }
        if (sum == G) break;
        __builtin_amdgcn_s_sleep(1);
        if ((++sp & 255u) == 0u) { if (xb_ld(&bar[XB_TMO])) break; if (sp > XB_SPIN_CAP) { atomicAdd(&bar[XB_TMO], 1u); break; } }
    }
    nloc = mine > 0u ? mine : 1u; nx = cnt > 0u ? cnt : 1u;
}

__device__ __forceinline__ void xcd_barrier(const XcdBarrier& b) {
    asm volatile("s_waitcnt vmcnt(0)" ::: "memory");
    __syncthreads();
    if (threadIdx.x == 0) {
        unsigned* bar = b.bar;
        __builtin_amdgcn_s_waitcnt(0);
        unsigned nloc = b.st[0], nx = b.st[1];
        if (nloc == 0u) { xcd_barrier_complete(bar, b.x, nloc, nx); b.st[0] = nloc; b.st[1] = nx; }
        const unsigned old = xb_add(&bar[XB_XSUB(b.x)], 1u);
        const unsigned gen = old / nloc;
        if (old + 1u == (gen + 1u) * nloc) {
            __builtin_amdgcn_fence(__ATOMIC_RELEASE, "agent");
            asm volatile("s_waitcnt vmcnt(0)" ::: "memory");
            const unsigned og = xb_add(&bar[XB_TOP], 1u);
            const unsigned tg = og / nx;
            if (og + 1u == (tg + 1u) * nx) xb_add(&bar[XB_TOPGEN], 1u);
            else XB_SPIN(xb_ld(&bar[XB_TOPGEN]) == tg, bar);
            __builtin_amdgcn_fence(__ATOMIC_ACQUIRE, "agent");
            xb_add(&bar[XB_XGEN(b.x)], 1u);
            asm volatile("s_waitcnt vmcnt(0)" ::: "memory");
        } else {
            XB_SPIN(xb_ld(&bar[XB_XGEN(b.x)]) == gen, bar);
            __builtin_amdgcn_fence(__ATOMIC_ACQUIRE, "agent");
            asm volatile("s_waitcnt vmcnt(0)" ::: "memory");
        }
    }
    __syncthreads();
}

struct Args { const float* in[15]; float* out; unsigned char* ws; int ph_lo, ph_hi, li, pad; };
struct Frame {
    LAS unsigned char* lds;
    volatile LAS unsigned* MISC;
    gu32* ctl;
    int tid, lane, wave;
    int vcu, G;
    float* out;
    unsigned char* ws;
};
#define F_x (args.in[0])
#define F_c (args.in[1])
#define F_norm1_g (args.in[2])
#define F_w_in (args.in[3])
#define F_hg_lb_logits (args.in[4])
#define F_hg_out_g (args.in[5])
#define F_sb_q_g (args.in[6])
#define F_sb_k_g (args.in[7])
#define F_sb_out_g (args.in[8])
#define F_w_out (args.in[9])
#define F_norm2_g (args.in[10])
#define F_w_ffn_in (args.in[11])
#define F_w_ffn_out (args.in[12])
#define F_w_ada (args.in[13])
#define F_b_ada (args.in[14])
#define F_MOD ((float*)(F.ws + WS_MOD))
#define F_LB ((float*)(F.ws + WS_LB))
#define F_H ((bf16*)(F.ws + WS_H))
#define F_P16 ((bf16*)(F.ws + WS_P16))
#define F_MIX ((bf16*)(F.ws + WS_MIX))
#define F_HID ((bf16*)(F.ws + WS_HID))
template <int CTRL> __device__ __forceinline__ float dpp_f(float v) { return __builtin_bit_cast(float, __builtin_amdgcn_update_dpp(0, __builtin_bit_cast(int, v), CTRL, 0xf, 0xf, false)); }
__device__ __forceinline__ float quad_sum(float v) { v += dpp_f<0xB1>(v); v += dpp_f<0x4E>(v); return v; }
__device__ __forceinline__ float row16_sum(float v) { v = quad_sum(v); v += dpp_f<0x141>(v); v += dpp_f<0x140>(v); return v; }
__device__ __forceinline__ float wave_sum(float v) {
    v = row16_sum(v);
    const int vi = __builtin_bit_cast(int, v);
    const float r0 = __builtin_bit_cast(float, __builtin_amdgcn_readlane(vi, 0)), r1 = __builtin_bit_cast(float, __builtin_amdgcn_readlane(vi, 16)), r2 = __builtin_bit_cast(float, __builtin_amdgcn_readlane(vi, 32)), r3 = __builtin_bit_cast(float, __builtin_amdgcn_readlane(vi, 48));
    return (r0 + r1) + (r2 + r3);
}

#define PHASE_FRAME(Fl) Frame Fl = F; { int t_ = F.tid; asm volatile("" : "+v"(t_)); Fl.tid = t_; Fl.lane = t_ & 63; Fl.wave = __builtin_amdgcn_readfirstlane(t_ >> 6); int v_ = F.vcu; asm volatile("" : "+s"(v_)); Fl.vcu = v_; }
__device__ __forceinline__ void transpose_item(const float* W, int K, int N, bf16* WT, int k0, int n_src0, int n_dst0, LAS float* scr, int lane, const float* sh, int sh_bstride, long long* cdst, int cstride) {
    LAS float* shl = scr + 64 * 33;
    if (sh) { shl[lane] = sh[k0 + lane]; shl[64 + lane] = sh[sh_bstride + k0 + lane]; }
#pragma unroll 8
    for (int i = 0; i < 32; ++i) { const int kk = 2 * i + (lane >> 5); scr[kk * 33 + (lane & 31)] = W[(size_t)(k0 + kk) * N + n_src0 + (lane & 31)]; }
    LDS_WAIT(); asm volatile("" ::: "memory");
    const int c = lane & 7;
#pragma unroll
    for (int j = 0; j < 4; ++j) { const int n = (lane >> 3) + 8 * j; const LAS float* s = scr + (8 * c) * 33 + n;
        v4u o; o.x = pk2(s[0 * 33], s[1 * 33]); o.y = pk2(s[2 * 33], s[3 * 33]); o.z = pk2(s[4 * 33], s[5 * 33]); o.w = pk2(s[6 * 33], s[7 * 33]);
        *(GAS v4u*)(WT + (size_t)(n_dst0 + n) * K + k0 + 8 * c) = o; }
    if (sh) { const int n = lane & 31, hf = lane >> 5; float s0 = 0.f, s1 = 0.f;
#pragma unroll 8
        for (int i = 0; i < 32; ++i) { const int kk = 32 * hf + i; const float w = scr[kk * 33 + n]; s0 += shl[kk] * w; s1 += shl[64 + kk] * w; }
        s0 += __shfl_xor(s0, 32); s1 += __shfl_xor(s1, 32);
        if (hf == 0) { pg8::fx_add(cdst + n_dst0 + n, s0, pg8::C_SCALE); pg8::fx_add(cdst + cstride + n_dst0 + n, s1, pg8::C_SCALE); } }
    LDS_WAIT(); asm volatile("" ::: "memory");
}
__device__ __forceinline__ void mod_unit(Frame& F, const Args& args, int unit) {
    const int l = unit / 48, cb = unit % 48;
    LAS float* cond = (LAS float*)(F.lds);
    LAS float* part = (LAS float*)(F.lds + 16384);
    for (int i = F.tid; i < 2 * DM; i += NWAVES * 64) { const float v = F_c[i]; cond[i] = v / (1.0f + __expf(-v)); }
    __syncthreads();
    const float* W = F_w_ada + (size_t)l * DM * NMODC + cb * 256 + F.lane * 4;
    f32x4 a0 = {0.f, 0.f, 0.f, 0.f}, a1 = {0.f, 0.f, 0.f, 0.f};
    const int kb = F.wave * 256;
#pragma unroll 32
    for (int k = 0; k < 256; ++k) { const f32x4 w = *(const GAS f32x4*)(W + (size_t)(kb + k) * NMODC); a0 += cond[kb + k] * w; a1 += cond[DM + kb + k] * w; }
    *(LAS f32x4*)(part + (F.wave * 2 + 0) * 256 + F.lane * 4) = a0;
    *(LAS f32x4*)(part + (F.wave * 2 + 1) * 256 + F.lane * 4) = a1;
    __syncthreads();
    { const int b = F.tid >> 8, col = F.tid & 255; float s = F_b_ada[l * NMODC + cb * 256 + col];
#pragma unroll
      for (int w = 0; w < 8; ++w) s += part[(w * 2 + b) * 256 + col];
      F_MOD[(size_t)(l * 2 + b) * NMODC + cb * 256 + col] = s; }
    __syncthreads();
}
__device__ __forceinline__ void lb_table(Frame& F, const Args& args) {
    for (int d = F.tid; d < HGW; d += NWAVES * 64) {
        const float x0 = F_hg_lb_logits[d], x1 = F_hg_lb_logits[HGW + d], x2 = F_hg_lb_logits[2 * HGW + d], x3 = F_hg_lb_logits[3 * HGW + d];
        const float mx = fmaxf(fmaxf(x0, x1), fmaxf(x2, x3));
        const float e0 = expf(x0 - mx), e1 = expf(x1 - mx), e2 = expf(x2 - mx), e3 = expf(x3 - mx), inv = 1.0f / (e0 + e1 + e2 + e3);
        const float p1 = e1 * inv, p2 = e2 * inv, p3 = e3 * inv;
        F_LB[d] = 0.f; F_LB[HGW + d] = p1; F_LB[2 * HGW + d] = p1 + p2; F_LB[3 * HGW + d] = (p1 + p2) + p3;
    }
}
__device__ __forceinline__ void p0_prologue_a(Frame& F, const Args& args) {
    if (F.vcu < DEPTH * 16) { const int l = F.vcu >> 4, j = F.vcu & 15; mod_unit(F, args, l * 48 + ((j < 8) ? j : 24 + (j - 8))); }
    if (F.vcu == F.G - 1) lb_table(F, args);
    __syncthreads();
    LAS float* scr = (LAS float*)(F.lds + RING_OFF + F.wave * 16384);
    const int gw = F.vcu * NWAVES + F.wave, NGW = F.G * NWAVES;
    constexpr int I_OUT = (DM / 64) * (DM / 32), I_FO = (DFF / 64) * (DM / 32), I_LAYER = I_OUT + I_FO;
    for (int it = gw; it < DEPTH * I_LAYER; it += NGW) {
        const int l = it / I_LAYER; int r = it % I_LAYER;
        unsigned char* wt = F.ws + WS_WT + (size_t)l * WT_LAYER;
        if (r < I_OUT) { const int nblk = DM / 32, kb = r / nblk, nb = r % nblk;
            transpose_item(F_w_out + (size_t)l * DM * DM, DM, DM, (bf16*)(wt + WT_OUT), 64 * kb, 32 * nb, 32 * nb, scr, F.lane, nullptr, 0, nullptr, 0); continue; } r -= I_OUT;
        { const int nblk = DM / 32, kb = r / nblk, nb = r % nblk;
            transpose_item(F_w_ffn_out + (size_t)l * DFF * DM, DFF, DM, (bf16*)(wt + WT_FO), 64 * kb, 32 * nb, 32 * nb, scr, F.lane, nullptr, 0, nullptr, 0); }
    }
}
__device__ __forceinline__ void p0_prologue_b(Frame& F, const Args& args) {
    if (F.vcu < DEPTH * 32) { const int l = F.vcu >> 5, j = F.vcu & 31; mod_unit(F, args, l * 48 + ((j < 16) ? 8 + j : 32 + (j - 16))); }
    __syncthreads();
    LAS float* scr = (LAS float*)(F.lds + RING_OFF + F.wave * 16384);
    const int gw = F.vcu * NWAVES + F.wave, NGW = F.G * NWAVES;
    constexpr int I_IN = (DM / 64) * (INC / 32), I_FI = (DM / 64) * (2 * DFF / 32), I_LAYER = I_IN + I_FI;
    for (int it = gw; it < DEPTH * I_LAYER; it += NGW) {
        const int l = it / I_LAYER; int r = it % I_LAYER;
        unsigned char* wt = F.ws + WS_WT + (size_t)l * WT_LAYER;
        const float* modl = F_MOD + (size_t)l * 2 * NMODC;
        if (r < I_IN) { const int nblk = INC / 32, kb = r / nblk, nb = r % nblk;
            transpose_item(F_w_in + (size_t)l * DM * INC, DM, INC, (bf16*)(wt + WT_IN), 64 * kb, 32 * nb, 32 * nb, scr, F.lane, modl, NMODC, (long long*)(F.ws + WS_C1) + (size_t)l * BATCH * INC, INC); continue; } r -= I_IN;
        { const int nblk = 2 * DFF / 32, kb = r / nblk, nb = r % nblk, p = nb >> 3, q = nb & 7;
            const int nsrc = (q < 4) ? (128 * p + 32 * q) : (DFF + 128 * p + 32 * (q - 4));
            transpose_item(F_w_ffn_in + (size_t)l * DM * 2 * DFF, DM, 2 * DFF, (bf16*)(wt + WT_FI), 64 * kb, nsrc, 32 * nb, scr, F.lane, modl + 3 * DM, NMODC, (long long*)(F.ws + WS_C2) + (size_t)l * BATCH * 2 * DFF, 2 * DFF); }
    }
}
__device__ __forceinline__ void norm0_phase(Frame& F, const float* x, const float* g, const float* modl, int sc_off, long long* ss) {
    const int gw = F.vcu * NWAVES + F.wave, NGW = F.G * NWAVES;
    for (int row = gw; row < M; row += NGW) {
        const float* mb = modl + (size_t)(row / SEQ) * NMODC;
        const GAS f32x4* xr = (const GAS f32x4*)(x + (size_t)row * DM) + F.lane;
        f32x4 v[8]; float s = 0.f;
#pragma unroll
        for (int j = 0; j < 8; ++j) { v[j] = xr[64 * j]; s += (v[j].x * v[j].x + v[j].y * v[j].y) + (v[j].z * v[j].z + v[j].w * v[j].w); }
        s = wave_sum(s);
        if (F.lane == 0) ss[row] = __float2ll_rn(s * pg8::SS_SCALE);
        GAS v2u* o8 = (GAS v2u*)(F_H + (size_t)row * DM) + F.lane;
#pragma unroll
        for (int j = 0; j < 8; ++j) { const int col = 4 * F.lane + 256 * j;
            const f32x4 gg = *(const GAS f32x4*)(g + col), sc = *(const GAS f32x4*)(mb + sc_off + col);
            const f32x4 y = v[j] * gg * (1.0f + sc);
            v2u w; w.x = pk2(y.x, y.y); w.y = pk2(y.z, y.w); o8[64 * j] = w; }
    }
}

typedef short bf16x8 __attribute__((ext_vector_type(8)));
constexpr int P16S = pg8::P16_LD;
constexpr int TS = 136;
constexpr int VS = 72;
constexpr int VR = 144;
constexpr int HG_UNITS = BATCH * NH * (SEQ / 64);
typedef short s16x4 __attribute__((ext_vector_type(4)));
__device__ __forceinline__ bf16x8 tr_frag(const LAS unsigned short* p0, const LAS unsigned short* p1) {
    const s16x4 a = __builtin_bit_cast(s16x4, __builtin_amdgcn_ds_read_tr16_b64_v4i16((LAS s16x4*)p0)), b = __builtin_bit_cast(s16x4, __builtin_amdgcn_ds_read_tr16_b64_v4i16((LAS s16x4*)p1));
    return (bf16x8){a[0], a[1], a[2], a[3], b[0], b[1], b[2], b[3]};
}
#define LDS_BARRIER() do { asm volatile("s_waitcnt lgkmcnt(0)" ::: "memory"); __builtin_amdgcn_s_barrier(); asm volatile("" ::: "memory"); } while (0)
#define MFMA16(X, Y, C) __builtin_amdgcn_mfma_f32_16x16x32_bf16((X), (Y), (C), 0, 0, 0)
__device__ __forceinline__ f32x2 expv(f32x2 v) { const f32x2 t = v * 1.4426950408889634f; return (f32x2){__builtin_amdgcn_exp2f(t.x), __builtin_amdgcn_exp2f(t.y)}; }
__device__ __forceinline__ f32x2 minv(f32x2 v, float m) { return (f32x2){fminf(v.x, m), fminf(v.y, m)}; }
__device__ __forceinline__ f32x2 h2v(unsigned w) { return (f32x2){h2f((unsigned short)(w & 0xffffu)), h2f((unsigned short)(w >> 16))}; }
__device__ __forceinline__ unsigned pk2v(f32x2 v) { return pk2(v.x, v.y); }


struct HgRegs { unsigned lf[8], q[8]; v4u v[2]; };
template <bool WANT_Q> __device__ __forceinline__ void hg_issue(Frame& F, HgRegs& R, int u) {
    const int bh = u >> 7, c = u & 127, b = bh >> 3, h = bh & 7, dp = F.tid & 63, grp = F.tid >> 6;
    const bf16* P = F_P16 + (size_t)(b * SEQ + 64 * c) * P16S + h * HD;
#pragma unroll
    for (int j = 0; j < 8; ++j) { const bf16* src = P + (size_t)(8 * grp + j) * P16S + 2 * dp;
        R.lf[j] = *(const GAS unsigned*)(src + 1024); if (WANT_Q) R.q[j] = *(const GAS unsigned*)(src); }
#pragma unroll
    for (int i = 0; i < 2; ++i) { const int ch = F.tid + 512 * i, r = ch >> 4, cc = ch & 15; R.v[i] = *(const GAS v4u*)(P + (size_t)r * P16S + 2048 + cc * 8); }
}
__device__ __forceinline__ void hgrn2_a1_all(Frame& F) {
    constexpr int SET = 64 * VR * 2 + 8 * 128 * 2;
    const int dp = F.tid & 63, grp = F.tid >> 6, g = F.lane >> 4, li = F.lane & 15;
    HgRegs R; int u = F.vcu, par = 0;
    if (u < HG_UNITS) hg_issue<false>(F, R, u);
    while (u < HG_UNITS) {
        LAS unsigned short* Lk = (LAS unsigned short*)(F.lds) + par * SET;
        LAS unsigned short* Lv = Lk + 64 * VR;
        LAS float* Ltot = (LAS float*)(Lv + 64 * VR);
        f32x2 bl[8]; { f32x2 r = {0.f, 0.f};
#pragma unroll
            for (int j = 0; j < 8; ++j) { r += h2v(R.lf[j]); bl[j] = r; }
            *(LAS f32x2*)(Ltot + grp * 128 + 2 * dp) = r; }
#pragma unroll
        for (int i = 0; i < 2; ++i) { const int ch = F.tid + 512 * i, r = ch >> 4, cc = ch & 15; *(LAS v4u*)(Lv + r * VR + cc * 8) = R.v[i]; }
        LDS_BARRIER();
        { f32x2 off = {0.f, 0.f}, tot = {0.f, 0.f};
#pragma unroll
          for (int gg = 0; gg < 8; ++gg) { const f32x2 t = *(const LAS f32x2*)(Ltot + gg * 128 + 2 * dp); if (gg < grp) off += t; tot += t; }
#pragma unroll
          for (int j = 0; j < 8; ++j) { const f32x2 key = 1.0f - expv(h2v(R.lf[j]));
              *(LAS unsigned*)(Lk + (8 * grp + j) * VR + 2 * dp) = pk2v(key * expv(tot - (bl[j] + off))); }
          if (grp == 0) *(GAS f32x2*)((float*)(F.ws + WS_DEC) + (size_t)u * 128 + 2 * dp) = expv(tot); }
        LDS_BARRIER();
        const int un = u + F.G;
        if (un < HG_UNITS) hg_issue<false>(F, R, un);
        { const LAS unsigned short* xb = Lk + (4 * g + (li >> 2)) * VR + 16 * F.wave + 4 * (li & 3);
          const LAS unsigned short* yb = Lv + (4 * g + (li >> 2)) * VR + 4 * (li & 3);
          const bf16x8 X0 = tr_frag(xb, xb + 16 * VR), X1 = tr_frag(xb + 32 * VR, xb + 48 * VR);
          bf16* so = (bf16*)(F.ws + WS_SLOC) + (size_t)u * 16384 + 16 * F.wave + 4 * g;
#pragma unroll
          for (int eb = 0; eb < 8; ++eb) { const bf16x8 Y0 = tr_frag(yb + 16 * eb, yb + 16 * eb + 16 * VR), Y1 = tr_frag(yb + 16 * eb + 32 * VR, yb + 16 * eb + 48 * VR);
              f32x4 acc = {0.f, 0.f, 0.f, 0.f}; acc = MFMA16(X0, Y0, acc); acc = MFMA16(X1, Y1, acc);
              v2u w; w.x = pk2(acc[0], acc[1]); w.y = pk2(acc[2], acc[3]);
              *(GAS v2u*)(so + (size_t)(16 * eb + li) * 128) = w; } }
        u = un; par ^= 1;
    }
    LDS_BARRIER();
}
__device__ __forceinline__ void hgrn2_a2(Frame& F) {
    const int NGW = F.G * NWAVES;
    for (int row = F.vcu * NWAVES + F.wave; row < BATCH * NH * 128; row += NGW) {
        const int bh = row >> 7, e = row & 127;
        const GAS unsigned* base = (const GAS unsigned*)(F.ws + WS_SLOC) + ((size_t)bh * 128 * 128 + e) * 64 + F.lane;
        GAS unsigned* obase = (GAS unsigned*)(F.ws + WS_SPREV) + ((size_t)bh * 128 * 128 + e) * 64 + F.lane;
        const GAS f32x2* dbase = (const GAS f32x2*)(F.ws + WS_DEC) + (size_t)bh * 128 * 64 + F.lane;
        float S0 = 0.f, S1 = 0.f;
        for (int c0 = 0; c0 < 128; c0 += 32) {
            unsigned loc[32]; f32x2 dc[32];
#pragma unroll
            for (int j = 0; j < 32; ++j) { loc[j] = __builtin_nontemporal_load(base + (size_t)(c0 + j) * 8192); dc[j] = dbase[(c0 + j) * 64]; }
#pragma unroll
            for (int j = 0; j < 32; ++j) { obase[(size_t)(c0 + j) * 8192] = pk2(S0, S1); S0 = dc[j].x * S0 + bflo(loc[j]); S1 = dc[j].y * S1 + bfhi(loc[j]); }
        }
    }
}

__device__ __forceinline__ void hgrn2_a3_all(Frame& F, const Args& args, int layer) {
    LAS unsigned short* Lq = (LAS unsigned short*)(F.lds);
    LAS unsigned short* Lk = Lq + 64 * TS;
    LAS unsigned short* Li = Lk + 64 * TS;
    LAS unsigned short* Lv = Li + 64 * TS;
    LAS unsigned short* LP = Lv + 64 * VR;
    LAS float* Lo = (LAS float*)(LP + 64 * VS);
    LAS float* Ltot = Lo + 64 * 132;
    const int dp = F.tid & 63, grp = F.tid >> 6, g = F.lane >> 4, li = F.lane & 15;
    HgRegs R; bf16x8 Spn[4]; unsigned gate[8]; f32x2 ogn; int u = F.vcu;
#define A3_ISSUE(uu) do { hg_issue<true>(F, R, (uu)); const int bh_ = (uu) >> 7, c_ = (uu) & 127; \
        const bf16* sp_ = (const bf16*)(F.ws + WS_SPREV) + (size_t)(uu) * 16384 + (size_t)(16 * F.wave + li) * 128 + 8 * g; \
        _Pragma("unroll") for (int kd = 0; kd < 4; ++kd) Spn[kd] = *(const GAS bf16x8*)(sp_ + 32 * kd); \
        const bf16* gp_ = F_P16 + (size_t)((bh_ >> 3) * SEQ + 64 * c_ + 8 * F.wave) * P16S + 3072 + (bh_ & 7) * HD + 2 * F.lane; \
        _Pragma("unroll") for (int rr = 0; rr < 8; ++rr) gate[rr] = *(const GAS unsigned*)(gp_ + (size_t)rr * P16S); \
        ogn = *(const GAS f32x2*)(F_hg_out_g + layer * HGW + (bh_ & 7) * HD + 2 * F.lane); } while (0)
    if (u < HG_UNITS) A3_ISSUE(u);
    while (u < HG_UNITS) {
        const int bh = u >> 7, c = u & 127, b = bh >> 3, h = bh & 7;
        const size_t row0 = (size_t)(b * SEQ + 64 * c);
        f32x2 bl[8]; { f32x2 r = {0.f, 0.f};
#pragma unroll
            for (int j = 0; j < 8; ++j) { r += h2v(R.lf[j]); bl[j] = r; }
            *(LAS f32x2*)(Ltot + grp * 128 + 2 * dp) = r; }
#pragma unroll
        for (int i = 0; i < 2; ++i) { const int ch = F.tid + 512 * i, r = ch >> 4, cc = ch & 15; *(LAS v4u*)(Lv + r * VR + cc * 8) = R.v[i]; }
        LDS_BARRIER();
        { f32x2 off = {0.f, 0.f}, ref = {0.f, 0.f};
#pragma unroll
          for (int gg = 0; gg < 7; ++gg) { const f32x2 t = *(const LAS f32x2*)(Ltot + gg * 128 + 2 * dp); if (gg < grp) off += t; if (gg < 4) ref += t; }
#pragma unroll
          for (int j = 0; j < 8; ++j) { const int s = 8 * grp + j; const f32x2 b = bl[j] + off, q = {bflo(R.q[j]), bfhi(R.q[j])};
              *(LAS unsigned*)(Lq + s * TS + 2 * dp) = pk2v(q * expv(minv(b - ref, 80.f)));
              const f32x2 key = 1.0f - expv(h2v(R.lf[j]));
              *(LAS unsigned*)(Lk + s * TS + 2 * dp) = pk2v(key * expv(minv(ref - b, 80.f)));
              *(LAS unsigned*)(Li + s * TS + 2 * dp) = pk2v(q * expv(b)); } }
        bf16x8 Sp[4]; unsigned gw[8];
#pragma unroll
        for (int kd = 0; kd < 4; ++kd) Sp[kd] = Spn[kd];
#pragma unroll
        for (int rr = 0; rr < 8; ++rr) gw[rr] = gate[rr];
        const f32x2 og = ogn;
        LDS_BARRIER();
        const int un = u + F.G;
        if (un < HG_UNITS) A3_ISSUE(un);
#pragma unroll
        for (int k2 = 0; k2 < 2; ++k2) { const int id = 2 * F.wave + k2, si = id >> 2, ti = id & 3;
            f32x4 acc = {0.f, 0.f, 0.f, 0.f};
            if (si <= ti) {
#pragma unroll
                for (int kd = 0; kd < 4; ++kd) { const bf16x8 X = *(const LAS bf16x8*)(Lk + (16 * si + li) * TS + 32 * kd + 8 * g), Y = *(const LAS bf16x8*)(Lq + (16 * ti + li) * TS + 32 * kd + 8 * g);
                    acc = MFMA16(X, Y, acc); }
                const int t = 16 * ti + li, s0 = 16 * si + 4 * g;
#pragma unroll
                for (int r = 0; r < 4; ++r) acc[r] = (s0 + r <= t) ? acc[r] : 0.f; }
            v2u w; w.x = pk2(acc[0], acc[1]); w.y = pk2(acc[2], acc[3]);
            *(LAS v2u*)(LP + (16 * ti + li) * VS + 16 * si + 4 * g) = w; }
        LDS_BARRIER();
        { f32x4 acc[4];
#pragma unroll
          for (int ti = 0; ti < 4; ++ti) acc[ti] = (f32x4){0.f, 0.f, 0.f, 0.f};
          const LAS unsigned short* yb = Lv + (4 * g + (li >> 2)) * VR + 16 * F.wave + 4 * (li & 3);
#pragma unroll
          for (int ks = 0; ks < 2; ++ks) { const bf16x8 Y = tr_frag(yb + 32 * ks * VR, yb + (32 * ks + 16) * VR);
#pragma unroll
              for (int ti = 0; ti < 4; ++ti) { const LAS unsigned short* pp = LP + (16 * ti + li) * VS + 32 * ks + 4 * g; const v2u x0 = *(const LAS v2u*)(pp), x1 = *(const LAS v2u*)(pp + 16);
                  acc[ti] = MFMA16(__builtin_bit_cast(bf16x8, (v4u){x0.x, x0.y, x1.x, x1.y}), Y, acc[ti]); } }
#pragma unroll
          for (int kd = 0; kd < 4; ++kd) {
#pragma unroll
              for (int ti = 0; ti < 4; ++ti) { const bf16x8 X = *(const LAS bf16x8*)(Li + (16 * ti + li) * TS + 32 * kd + 8 * g); acc[ti] = MFMA16(X, Sp[kd], acc[ti]); } }
#pragma unroll
          for (int ti = 0; ti < 4; ++ti)
#pragma unroll
              for (int r = 0; r < 4; ++r) Lo[(16 * ti + 4 * g + r) * 132 + 16 * F.wave + li] = acc[ti][r]; }
        LDS_BARRIER();
        {
#pragma unroll
          for (int rr = 0; rr < 8; ++rr) { const int t = 8 * F.wave + rr; const size_t row = row0 + t;
              const f32x2 o = *(const LAS f32x2*)(Lo + t * 132 + 2 * F.lane);
              const float rstd = __builtin_amdgcn_rsqf(wave_sum(o.x * o.x + o.y * o.y) * (1.0f / HD) + EPS);
              *(GAS unsigned*)(F_MIX + row * DM + h * HD + 2 * F.lane) = pk2(o.x * rstd * og.x * bflo(gw[rr]), o.y * rstd * og.y * bfhi(gw[rr])); } }
        u = un;
    }
    LDS_BARRIER();
#undef A3_ISSUE
}

constexpr int AT_UNITS = BATCH * NH * (SEQ / 128);
constexpr float AT_STOP = 7.888609052210118e-31f;
struct AtRegs { v4u k[4], v[4]; };
__device__ __forceinline__ void at_issue(AtRegs& R, const bf16* Pb, int kb, int lr, int lc) {
#pragma unroll
    for (int i = 0; i < 4; ++i) { const bf16* src = Pb + (size_t)(128 * kb + lr + 32 * i) * P16S + lc * 8; R.k[i] = *(const GAS v4u*)(src + 5120); R.v[i] = *(const GAS v4u*)(src + 6144); }
}
__device__ __forceinline__ void at_half(Frame& F, int kb64, int hb, int tw, const LAS unsigned short* LKh, const LAS unsigned short* LVh, const bf16x8 (&Qf)[4], f32x4 (&O)[8], float& run) {
    const int g = F.lane >> 4, li = F.lane & 15, t = tw + li; const int kb = kb64; const LAS unsigned short* LK = LKh; const LAS unsigned short* LV = LVh;
    {
        f32x4 kp[4], sg[4];
#pragma unroll
        for (int sb = 0; sb < 4; ++sb) { f32x4 acc = {0.f, 0.f, 0.f, 0.f};
#pragma unroll
            for (int kd = 0; kd < 4; ++kd) { const bf16x8 X = *(const LAS bf16x8*)(LK + (16 * sb + li) * TS + 32 * kd + 8 * g); acc = MFMA16(X, Qf[kd], acc); }
#pragma unroll
            for (int r = 0; r < 4; ++r) acc[r] = __builtin_amdgcn_exp2f(acc[r]);
            const f32x4 den = acc + 1.0f;
#pragma unroll
            for (int r = 0; r < 4; ++r) { const bool valid = (64 * kb + 16 * sb + 4 * g + r) < t; kp[sb][r] = valid ? __builtin_amdgcn_rcpf(den[r]) : 1.0f; }
            sg[sb] = 1.0f - kp[sb]; }
        float excl[4], TT[4], e1[4], e0[4];
#pragma unroll
        for (int sb = 0; sb < 4; ++sb) { e1[sb] = kp[sb][3] * kp[sb][2]; e0[sb] = e1[sb] * kp[sb][1]; const float T = e0[sb] * kp[sb][0];
            const float x1 = __shfl(T, (F.lane + 16) & 63), x2 = __shfl(T, (F.lane + 32) & 63), x3 = __shfl(T, (F.lane + 48) & 63);
            excl[sb] = (((g < 3) ? x1 : 1.0f) * ((g < 2) ? x2 : 1.0f)) * ((g < 1) ? x3 : 1.0f);
            TT[sb] = (T * ((g & 1) ? x3 : x1)) * (x2 * ((g & 1) ? x1 : x3)); }
        float off = run; bf16x8 X[2];
        { unsigned p[8];
#pragma unroll
          for (int sb = 3; sb >= 0; --sb) { const float base = off * excl[sb]; off *= TT[sb];
              const float a3 = base * sg[sb][3], a2 = base * kp[sb][3] * sg[sb][2], a1 = base * e1[sb] * sg[sb][1], a0 = base * e0[sb] * sg[sb][0];
              p[2 * sb] = pk2(a0, a1); p[2 * sb + 1] = pk2(a2, a3); }
          X[0] = __builtin_bit_cast(bf16x8, (v4u){p[0], p[1], p[2], p[3]}); X[1] = __builtin_bit_cast(bf16x8, (v4u){p[4], p[5], p[6], p[7]}); }
        run = off;
#pragma unroll
        for (int eb = 0; eb < 8; ++eb)
#pragma unroll
            for (int ks = 0; ks < 2; ++ks) { const LAS unsigned short* vp = LV + (32 * ks + 4 * g + (li >> 2)) * VR + 16 * eb + 4 * (li & 3);
                O[eb] = MFMA16(X[ks], tr_frag(vp, vp + 16 * VR), O[eb]); }
    }
}
__device__ __forceinline__ bool at_stage(Frame& F, AtRegs& R, const bf16* Pb, int kb, int tw, int lr, int lc, LAS unsigned short* LK, LAS unsigned short* LV, LAS unsigned* Lflag,
                                         const bf16x8 (&Qf)[4], f32x4 (&O)[8], float& run, bool& wdone, bool issue_next, AtRegs& Rn, v4u (&qn)[4], const bf16* Pbn, int tn, int qtn) {
    LDS_BARRIER();
    { unsigned all = 1u;
#pragma unroll
      for (int w = 0; w < 8; ++w) all &= Lflag[w];
      if (__builtin_amdgcn_readfirstlane(all)) return true; }
#pragma unroll
    for (int i = 0; i < 4; ++i) { const int r = lr + 32 * i; const unsigned ka[4] = {R.k[i].x, R.k[i].y, R.k[i].z, R.k[i].w}; float kv[8]; float ss = 0.f;
#pragma unroll
        for (int j = 0; j < 4; ++j) { kv[2 * j] = bflo(ka[j]); kv[2 * j + 1] = bfhi(ka[j]); ss += kv[2 * j] * kv[2 * j] + kv[2 * j + 1] * kv[2 * j + 1]; }
        ss = row16_sum(ss);
        const float rk = __builtin_amdgcn_rsqf(ss * (1.0f / HD) + EPS);
        *(LAS v4u*)(LK + r * TS + lc * 8) = (v4u){pk2(kv[0] * rk, kv[1] * rk), pk2(kv[2] * rk, kv[3] * rk), pk2(kv[4] * rk, kv[5] * rk), pk2(kv[6] * rk, kv[7] * rk)};
        *(LAS v4u*)(LV + r * VR + lc * 8) = R.v[i]; }
    LDS_BARRIER();
    at_issue(R, Pb, (kb >= 1) ? (kb - 1) : 0, lr, lc);
    if (issue_next) {
        const int g_ = F.lane >> 4;
#pragma unroll
        for (int kd = 0; kd < 4; ++kd) qn[kd] = *(const GAS v4u*)(Pbn + (size_t)tn * P16S + 4096 + 32 * kd + 8 * g_);
        at_issue(Rn, Pbn, qtn, lr, lc); }
    if (!wdone && (128 * kb + 64 <= tw + 14)) { at_half(F, 2 * kb + 1, 1, tw, LK + 64 * TS, LV + 64 * VR, Qf, O, run); wdone = __all(run < AT_STOP); }
    if (!wdone && (128 * kb <= tw + 14)) { at_half(F, 2 * kb, 0, tw, LK, LV, Qf, O, run); wdone = __all(run < AT_STOP); }
    if (kb == 0) wdone = true;
    if (wdone && F.lane == 0) Lflag[F.wave] = 1u;
    return false;
}
__device__ __forceinline__ void attn_all(Frame& F, const Args& args, int layer) {
    LAS unsigned short* LK = (LAS unsigned short*)(F.lds);
    LAS unsigned short* LV = LK + 128 * TS;
    LAS unsigned* Lflag = (LAS unsigned*)(LV + 128 * VR);
    LAS float* Lo = (LAS float*)(F.lds) + F.wave * (16 * 132);
    const int g = F.lane >> 4, li = F.lane & 15, lr = F.tid >> 4, lc = F.tid & 15;
    LAS float* Lgqk = (LAS float*)(Lflag + 16); LAS float* Log = Lgqk + 128;
    if (F.tid < 128) Lgqk[F.tid] = F_sb_q_g[layer * HD + F.tid] * F_sb_k_g[layer * HD + F.tid] * (0.08838834764831845f * 1.4426950408889634f);
    for (int i = F.tid; i < HGW; i += NWAVES * 64) Log[i] = F_sb_out_g[layer * HGW + i];
    LDS_BARRIER();
    AtRegs R0, Rn; v4u qraw[4], qn[4];
    int u = F.vcu;
    if (u < AT_UNITS) { const int bh_ = u >> 6, qt_ = u & 63; const bf16* Pb_ = F_P16 + (size_t)((bh_ >> 3) * SEQ) * P16S + (bh_ & 7) * HD; const int t_ = 128 * qt_ + 16 * F.wave + li;
#pragma unroll
        for (int kd = 0; kd < 4; ++kd) qraw[kd] = *(const GAS v4u*)(Pb_ + (size_t)t_ * P16S + 4096 + 32 * kd + 8 * g);
        at_issue(R0, Pb_, qt_, lr, lc); }
    while (u < AT_UNITS) {
        const int bh = u >> 6, qt = u & 63, b = bh >> 3, h = bh & 7, t0 = 128 * qt, tw = t0 + 16 * F.wave;
        const bf16* Pb = F_P16 + (size_t)(b * SEQ) * P16S + h * HD;
        const int un = u + F.G; const bool has_next = un < AT_UNITS;
        const int bhn = has_next ? (un >> 6) : bh, qtn = has_next ? (un & 63) : qt; const bf16* Pbn = F_P16 + (size_t)((bhn >> 3) * SEQ) * P16S + (bhn & 7) * HD; const int tn = 128 * qtn + 16 * F.wave + li;
        bf16x8 Qf[4];
        { float qv[32]; float ss = 0.f;
#pragma unroll
          for (int kd = 0; kd < 4; ++kd) { const unsigned a[4] = {qraw[kd].x, qraw[kd].y, qraw[kd].z, qraw[kd].w};
#pragma unroll
              for (int j = 0; j < 4; ++j) { const float lo = bflo(a[j]), hi = bfhi(a[j]); qv[8 * kd + 2 * j] = lo; qv[8 * kd + 2 * j + 1] = hi; ss += lo * lo + hi * hi; } }
          ss += __shfl_xor(ss, 16); ss += __shfl_xor(ss, 32);
          const float rq = __builtin_amdgcn_rsqf(ss * (1.0f / HD) + EPS);
#pragma unroll
          for (int kd = 0; kd < 4; ++kd) { unsigned p[4];
              const f32x4 c0 = *(const LAS f32x4*)(Lgqk + 32 * kd + 8 * g), c1 = *(const LAS f32x4*)(Lgqk + 32 * kd + 8 * g + 4); const float cc[8] = {c0.x, c0.y, c0.z, c0.w, c1.x, c1.y, c1.z, c1.w};
#pragma unroll
              for (int j = 0; j < 4; ++j) p[j] = pk2(qv[8 * kd + 2 * j] * rq * cc[2 * j], qv[8 * kd + 2 * j + 1] * rq * cc[2 * j + 1]);
              Qf[kd] = __builtin_bit_cast(bf16x8, (v4u){p[0], p[1], p[2], p[3]}); } }
        float run = 1.0f;
        f32x4 O[8];
#pragma unroll
        for (int eb = 0; eb < 8; ++eb) O[eb] = (f32x4){0.f, 0.f, 0.f, 0.f};
        bool wdone = false, issued = false;
        if (F.tid < 8) Lflag[F.tid] = 0u;
        for (int kb = qt; kb >= 0; --kb) {
            const bool inow = has_next && !issued && (kb == qt - 1 || kb == 0);
            if (at_stage(F, R0, Pb, kb, tw, lr, lc, LK, LV, Lflag, Qf, O, run, wdone, inow, Rn, qn, Pbn, tn, qtn)) break;
            issued = issued || inow;
        }
        LDS_BARRIER();
        if (has_next && !issued) {
#pragma unroll
            for (int kd = 0; kd < 4; ++kd) qn[kd] = *(const GAS v4u*)(Pbn + (size_t)tn * P16S + 4096 + 32 * kd + 8 * g);
            at_issue(Rn, Pbn, qtn, lr, lc); }
#pragma unroll
        for (int eb = 0; eb < 8; ++eb)
#pragma unroll
            for (int r = 0; r < 4; ++r) Lo[(4 * g + r) * 132 + 16 * eb + li] = O[eb][r];
        LDS_WAIT(); asm volatile("" ::: "memory");
        { const int rr = F.lane >> 2, es = 32 * (F.lane & 3); f32x4 ov[8]; float ss = 0.f;
#pragma unroll
          for (int i = 0; i < 8; ++i) { ov[i] = *(const LAS f32x4*)(Lo + rr * 132 + es + 4 * i); ss += (ov[i].x * ov[i].x + ov[i].y * ov[i].y) + (ov[i].z * ov[i].z + ov[i].w * ov[i].w); }
          ss = quad_sum(ss);
          const float ro = __builtin_amdgcn_rsqf(ss * (1.0f / HD) + EPS);
          GAS v4u* op = (GAS v4u*)(F_MIX + (size_t)(b * SEQ + tw + rr) * DM + HGW + h * HD + es);
#pragma unroll
          for (int i = 0; i < 4; ++i) { const f32x4 a0 = ov[2 * i] * ro * *(const LAS f32x4*)(Log + h * HD + es + 8 * i), a1 = ov[2 * i + 1] * ro * *(const LAS f32x4*)(Log + h * HD + es + 8 * i + 4);
              op[i] = (v4u){pk2(a0.x, a0.y), pk2(a0.z, a0.w), pk2(a1.x, a1.y), pk2(a1.z, a1.w)}; } }
        LDS_BARRIER();
#pragma unroll
        for (int kd = 0; kd < 4; ++kd) qraw[kd] = qn[kd];
        R0 = Rn;
        u = un;
    }
}
__global__ void __launch_bounds__(NWAVES * 64, 2) skel_fwd(Args args) {
    extern __shared__ __attribute__((aligned(16))) unsigned char lds[];
    Frame F;
    F.lds = (LAS unsigned char*)lds;
    F.MISC = (volatile LAS unsigned*)(F.lds + MISC_OFF);
    F.tid = threadIdx.x; F.lane = F.tid & 63; F.wave = __builtin_amdgcn_readfirstlane(F.tid >> 6);
    F.G = gridDim.x; { const int bx = blockIdx.x; F.vcu = (F.G % 8 == 0) ? (bx % 8) * (F.G / 8) + bx / 8 : bx; }
    unsigned char* ws = args.ws; F.ws = ws; F.out = args.out;
    F.ctl = (gu32*)(ws + WS_CTL);
    for (int u = F.tid; u < (LDS_BYTES - LDSCTL_OFF) / 4; u += NWAVES * 64) ((LAS unsigned*)(F.lds + LDSCTL_OFF))[u] = 0u;
    __syncthreads();
    XcdBarrier bar; bar.bar = (unsigned*)(F.ctl + CW_BAR); bar.x = 0; bar.st = nullptr;
    if (!MK_PER_PHASE) bar = xcd_barrier_post((unsigned*)(F.ctl + CW_BAR), F.MISC + 8);
#define GRID_BAR(seam) do { if (MK_PER_PHASE) { if (F.tid == 0) __hip_atomic_store(F.ctl + CW_TMO, 0xBADBA0u | (unsigned)(seam), RLX_AGENT); } else { XcdBarrier b_ = bar; unsigned* p_ = b_.bar; asm volatile("" : "+s"(p_)); b_.bar = p_; xcd_barrier(b_); } } while (0)
    const int lo = args.ph_lo, hi = args.ph_hi;
#define IN(k) (lo <= (k) && (k) < hi)
#define BOTH(k) (IN(k) && IN((k) + 1))

    if (IN(0)) { PHASE_FRAME(Fl); p0_prologue_a(Fl, args); if (BOTH(0)) GRID_BAR(0); }
    if (IN(1)) { PHASE_FRAME(Fl); p0_prologue_b(Fl, args); if (BOTH(1)) GRID_BAR(1); }
    if (IN(2)) { PHASE_FRAME(Fl); norm0_phase(Fl, F_x, F_norm1_g, F_MOD, DM, (long long*)(ws + WS_SS));
        { constexpr int NC = DEPTH * BATCH * (INC + 2 * DFF); const long long* cfx = (const long long*)(ws + WS_C1); float* cf = (float*)(ws + WS_CF);
          for (int i = Fl.vcu * (NWAVES * 64) + Fl.tid; i < NC; i += Fl.G * NWAVES * 64) cf[i] = pg8::fx_get(cfx + i, pg8::C_INV); }
        if (BOTH(2)) GRID_BAR(2); }

    for (int l = 0; l < DEPTH; ++l) {
        const int p0 = 3 + NPL * l;
        const float* xin = (l == 0) ? F_x : F.out;
        bf16* xa = (bf16*)(ws + WS_XA);
        const float* modl = F_MOD + (size_t)l * 2 * NMODC;
        const unsigned char* wt = ws + WS_WT + (size_t)l * WT_LAYER;
        long long* ss1 = (long long*)(ws + WS_SS) + (size_t)(2 * l) * M; long long* ss2 = ss1 + M;
        if (IN(p0 + 0)) {
            pg8::Gemm g{F_H, (const bf16*)(wt + WT_IN), M, INC, DM}; pg8::StaticOrder S; S.init(M, INC, F.G, (int)blockIdx.x);
            pg8::EpiProj E{F_P16, F_LB + l * HGW, ss1, (const float*)(ws + WS_CF) + (size_t)l * BATCH * INC, INC, SEQ};
            pg8::gemm_phase<pg8::EpiProj, pg8::StaticOrder, true, true>(F.lds + RING_OFF, g, S, E);
            if (BOTH(p0 + 0)) GRID_BAR(p0 + 0);
        }
        if (IN(p0 + 1)) {
            PHASE_FRAME(Fl);
            hgrn2_a1_all(Fl);
            attn_all(Fl, args, l);
            if (BOTH(p0 + 1)) GRID_BAR(p0 + 1);
        }
        if (IN(p0 + 2)) { PHASE_FRAME(Fl); hgrn2_a2(Fl); if (BOTH(p0 + 2)) GRID_BAR(p0 + 2); }
        if (IN(p0 + 3)) {
            PHASE_FRAME(Fl);
            hgrn2_a3_all(Fl, args, l);
            if (BOTH(p0 + 3)) GRID_BAR(p0 + 3);
        }
        if (IN(p0 + 4)) {
            pg8::Gemm g{F_MIX, (const bf16*)(wt + WT_OUT), M, DM, DM}; pg8::StaticOrder S; S.init(M, DM, F.G, (int)blockIdx.x);
            pg8::EpiResid<true, false> E{xin, nullptr, xa, modl + 2 * DM, NMODC, SEQ, F_H, F_norm2_g + l * DM, modl + 4 * DM, ss2};
            pg8::gemm_phase<pg8::EpiResid<true, false>, pg8::StaticOrder, false, true>(F.lds + RING_OFF, g, S, E);
            if (BOTH(p0 + 4)) GRID_BAR(p0 + 4);
        }
        if (IN(p0 + 5)) {
            pg8::Gemm g{F_H, (const bf16*)(wt + WT_FI), M, 2 * DFF, DM}; pg8::StaticOrder S; S.init(M, 2 * DFF, F.G, (int)blockIdx.x);
            pg8::EpiSwiGLU E{F_HID, DFF, ss2, (const float*)(ws + WS_CF) + (size_t)DEPTH * BATCH * INC + (size_t)l * BATCH * 2 * DFF, 2 * DFF, SEQ};
            pg8::gemm_phase<pg8::EpiSwiGLU, pg8::StaticOrder, true, true>(F.lds + RING_OFF, g, S, E);
            if (BOTH(p0 + 5)) GRID_BAR(p0 + 5);
        }
        if (IN(p0 + 6)) {
            pg8::Gemm g{F_HID, (const bf16*)(wt + WT_FO), M, DM, DFF}; pg8::StaticOrder S; S.init(M, DM, F.G, (int)blockIdx.x);
            const bool nxt = (l + 1 < DEPTH);
            pg8::EpiResid<false, true> E{xin, F.out, xa, modl + 5 * DM, NMODC, SEQ, nxt ? F_H : nullptr, F_norm1_g + (nxt ? l + 1 : l) * DM, F_MOD + (size_t)(nxt ? l + 1 : l) * 2 * NMODC + DM, nxt ? ss2 + M : ss2};
            pg8::gemm_phase<pg8::EpiResid<false, true>, pg8::StaticOrder, false, true>(F.lds + RING_OFF, g, S, E);
            if (BOTH(p0 + 6)) GRID_BAR(p0 + 6);
        }
    }
#undef IN
#undef BOTH
}

extern "C" void kernel_launch(void* const* d_in, const int* in_sizes, int n_in, void* d_out, int out_size, void* d_ws, size_t ws_size, hipStream_t stream) {
    static int grid = 0;
    if (grid == 0) {
        if (n_in != 15 || in_sizes[0] != M * DM || out_size != M * DM || ws_size < WS_END) { fprintf(stderr, "kernel_launch: unexpected shapes (n_in %d, in0 %d, out %d, ws %zu < %zu); nothing launched\n", n_in, n_in > 0 ? in_sizes[0] : -1, out_size, ws_size, (size_t)WS_END); grid = -1; return; }
        int dev = 0, cus = 0, per_cu = 0;
        if (hipGetDevice(&dev) != hipSuccess || hipDeviceGetAttribute(&cus, hipDeviceAttributeMultiprocessorCount, dev) != hipSuccess) { grid = -1; return; }
        if (hipFuncSetAttribute((const void*)skel_fwd, hipFuncAttributeMaxDynamicSharedMemorySize, LDS_BYTES) != hipSuccess) { fprintf(stderr, "kernel_launch: hipFuncSetAttribute failed\n"); grid = -1; return; }
        if (hipOccupancyMaxActiveBlocksPerMultiprocessor(&per_cu, (const void*)skel_fwd, NWAVES * 64, LDS_BYTES) != hipSuccess || per_cu < 1)
            fprintf(stderr, "kernel_launch: note: occupancy query reports %d workgroups per CU\n", per_cu);
        (void)hipGetLastError();
        grid = cus;
        if (grid > 256) grid = 256;
    }
    if (grid < 0) return;
    if (hipMemsetAsync((char*)d_ws + WS_CTL, 0, CTL_ZERO_BYTES, stream) != hipSuccess) return;
    Args a{};
    for (int i = 0; i < 15; ++i) a.in[i] = (const float*)d_in[i];
    a.out = (float*)d_out; a.ws = (unsigned char*)d_ws; a.li = 0; a.pad = 0;
#if MK_PER_PHASE
    for (int p = 0; p < NPH; ++p) { a.ph_lo = p; a.ph_hi = p + 1; hipLaunchKernelGGL(skel_fwd, dim3(grid), dim3(NWAVES * 64), LDS_BYTES, stream, a); }
#else
    a.ph_lo = 0; a.ph_hi = NPH;
    hipLaunchKernelGGL(skel_fwd, dim3(grid), dim3(NWAVES * 64), LDS_BYTES, stream, a);
#endif
}
```
